# Optimizing an MI355X kernel written in HIP

```python
import math
import jax, jax.numpy as jnp
from jax import lax
import numpy as np

D_MODEL = 1024
BATCH = 8
SEQ = 2048
DEPTH = 1
DEC_BATCH = 32
DEC_SEQ = 8
PAST_LEN = 8192
PAGE_SIZE = 128

MIX_WIDTH = D_MODEL
ATT_WIDTH = MIX_WIDTH // 2
HEAD_DIM = 64
N_HEADS = ATT_WIDTH // HEAD_DIM
POOL_WIDTH = MIX_WIDTH - ATT_WIDTH
POOL_WINDOWS = (2, 4, 8, 16)
N_POOL_GROUPS = len(POOL_WINDOWS)
POOL_GROUP_DIM = POOL_WIDTH // N_POOL_GROUPS
MAX_WINDOW = max(POOL_WINDOWS)
IN_WIDTH = 3 * ATT_WIDTH + N_HEADS + POOL_WIDTH
D_FF = ((8 * D_MODEL // 3 + 127) // 128) * 128
CONV_WIDTH = 3
Q_BLOCK = 128
LN_EPS = 1e-5
ATTN_SCALE = HEAD_DIM ** -0.5
ALPHA = (2 * DEPTH) ** 0.25
BETA = (8 * DEPTH) ** -0.25
FORGET_BIAS_MIN = 3.0
FORGET_BIAS_MAX = 10.0
FORGET_W_SCALE = 0.1
NEG_INF = -1e30

kernel_name = "hymba_fox_pool_convffn_step"


def _layer_norm(x, g, b):
    xf = x.astype(jnp.float32)
    mu = jnp.mean(xf, axis=-1, keepdims=True)
    var = jnp.mean(jnp.square(xf - mu), axis=-1, keepdims=True)
    y = (xf - mu) * lax.rsqrt(var + LN_EPS) * g.astype(jnp.float32) + b.astype(jnp.float32)
    return y.astype(x.dtype)


def _mixer_proj(x, w_in, b_f):
    B, T = x.shape[0], x.shape[1]
    p = jnp.einsum('btd,de->bte', x, w_in)
    q = p[..., :ATT_WIDTH].reshape(B, T, N_HEADS, HEAD_DIM)
    k = p[..., ATT_WIDTH:2 * ATT_WIDTH].reshape(B, T, N_HEADS, HEAD_DIM)
    v = p[..., 2 * ATT_WIDTH:3 * ATT_WIDTH].reshape(B, T, N_HEADS, HEAD_DIM)
    f_logit = p[..., 3 * ATT_WIDTH:3 * ATT_WIDTH + N_HEADS]
    u = p[..., 3 * ATT_WIDTH + N_HEADS:]
    logf = jax.nn.log_sigmoid(f_logit.astype(jnp.float32) + b_f.astype(jnp.float32))
    return q, k, v, logf, u


def _attend_block(q, k, v, qc, kc, q_pos, k_pos):
    s = jnp.einsum('bqhd,bkhd->bhqk', q, k).astype(jnp.float32) * ATTN_SCALE
    s = s + jnp.swapaxes(qc, 1, 2)[..., :, None] - jnp.swapaxes(kc, 1, 2)[..., None, :]
    causal = (q_pos[:, None] >= k_pos[None, :])[None, None]
    s = jnp.where(causal, s, NEG_INF)
    p = jax.nn.softmax(s, axis=-1)
    return jnp.einsum('bhqk,bkhd->bqhd', p.astype(v.dtype), v)


def _forget_attention(q, k, v, qc, kc, q_pos, k_pos, n_past):
    T = q.shape[1]
    outs = []
    for start in range(0, T, Q_BLOCK):
        end = min(start + Q_BLOCK, T)
        kend = n_past + end
        outs.append(_attend_block(q[:, start:end], k[:, :kend], v[:, :kend],
                                  qc[:, start:end], kc[:, :kend],
                                  q_pos[start:end], k_pos[:kend]))
    return jnp.concatenate(outs, axis=1)


def _multi_pool(u, buf, pos, w_pool, pool_scale):
    B, T = u.shape[0], u.shape[1]
    full = jnp.concatenate([buf.astype(u.dtype), u], axis=1)
    cs = jnp.cumsum(full.astype(jnp.float32), axis=1)
    cs = jnp.concatenate([jnp.zeros((B, 1, POOL_WIDTH), jnp.float32), cs], axis=1)
    uf = u.astype(jnp.float32)
    groups = []
    for g, w in enumerate(POOL_WINDOWS):
        lo, hi = g * POOL_GROUP_DIM, (g + 1) * POOL_GROUP_DIM
        end = cs[:, MAX_WINDOW:MAX_WINDOW + T, lo:hi]
        start = cs[:, MAX_WINDOW - w:MAX_WINDOW - w + T, lo:hi]
        cnt = jnp.minimum(pos + 1, w).astype(jnp.float32)[None, :, None]
        groups.append((end - start) / cnt - uf[..., lo:hi])
    pooled = jnp.stack(groups, axis=2).astype(u.dtype)
    mixed = jnp.einsum('btgc,gce->btge', pooled, w_pool).reshape(B, T, POOL_WIDTH)
    return mixed * pool_scale, full[:, T:]


def _conv_ffn(x, buf, w_up, b_up, w_conv, b_conv, w_down):
    T = x.shape[1]
    h = jnp.einsum('btd,df->btf', x, w_up) + b_up
    full = jnp.concatenate([buf.astype(h.dtype), h], axis=1)
    hc = b_conv + full[:, 0:T] * w_conv[0]
    for j in range(1, CONV_WIDTH):
        hc = hc + full[:, j:j + T] * w_conv[j]
    gate, val = hc[..., :D_FF], hc[..., D_FF:]
    out = jnp.einsum('btf,fd->btd', jax.nn.gelu(gate) * val, w_down)
    return out, full[:, T:]


def _layer(x, pos, k_past, v_past, kc_past, pool_buf, conv_buf,
           w_in, b_f, w_pool, pool_scale, w_out, ln1_g, ln1_b,
           w_up, b_up, w_conv, b_conv, w_down, ln2_g, ln2_b):
    B, T = x.shape[0], x.shape[1]
    n_past = k_past.shape[1]
    q, k, v, logf, u = _mixer_proj(x, w_in, b_f)
    qc = jnp.cumsum(logf, axis=1)
    kc = jnp.concatenate([kc_past, qc], axis=1)
    k_all = jnp.concatenate([k_past.astype(k.dtype), k], axis=1)
    v_all = jnp.concatenate([v_past.astype(v.dtype), v], axis=1)
    k_pos = jnp.arange(n_past + T, dtype=jnp.int32) + (pos[0] - n_past)
    att = _forget_attention(q, k_all, v_all, qc, kc, pos, k_pos, n_past)
    att = att.reshape(B, T, ATT_WIDTH)
    pool, new_pool = _multi_pool(u, pool_buf, pos, w_pool, pool_scale)
    mix = jnp.einsum('bte,ed->btd', jnp.concatenate([att, pool], axis=-1), w_out)
    x1 = _layer_norm(ALPHA * x + mix, ln1_g, ln1_b)
    ff, new_conv = _conv_ffn(x1, conv_buf, w_up, b_up, w_conv, b_conv, w_down)
    x2 = _layer_norm(ALPHA * x1 + ff, ln2_g, ln2_b)
    return x2, k, v, logf, new_pool, new_conv


def setup_inputs(seed: int = 0) -> dict:
    key = jax.random.key(seed)
    ks = jax.random.split(key, 24)
    f32 = jnp.float32
    n_pages = PAST_LEN // PAGE_SIZE
    n_used = DEC_BATCH * n_pages
    n_pool_pages = (n_used * 5) // 4
    nrm = lambda k, s: jax.random.normal(k, s, f32)
    x_prompt = nrm(ks[0], (BATCH, SEQ, D_MODEL))
    x_sample = nrm(ks[1], (DEC_BATCH, DEC_SEQ, D_MODEL))
    b_f = jnp.linspace(FORGET_BIAS_MIN, FORGET_BIAS_MAX, N_HEADS, dtype=f32)[None, :] \
        + 0.1 * nrm(ks[9], (DEPTH, N_HEADS))
    cache_k = nrm(ks[2], (DEPTH, n_pool_pages, PAGE_SIZE, N_HEADS, HEAD_DIM))
    cache_v = nrm(ks[3], (DEPTH, n_pool_pages, PAGE_SIZE, N_HEADS, HEAD_DIM))
    cache_logf = jax.nn.log_sigmoid(b_f[:, None, None, :]
                                    + 0.3 * nrm(ks[4], (DEPTH, n_pool_pages, PAGE_SIZE, N_HEADS)))
    state_pool = nrm(ks[5], (DEPTH, DEC_BATCH, MAX_WINDOW - 1, POOL_WIDTH))
    state_conv = nrm(ks[6], (DEPTH, DEC_BATCH, CONV_WIDTH - 1, 2 * D_FF))
    page_table = jax.random.permutation(ks[7], n_pool_pages)[:n_used].reshape(DEC_BATCH, n_pages).astype(jnp.int32)
    w_in = nrm(ks[8], (DEPTH, D_MODEL, IN_WIDTH)) * D_MODEL ** -0.5
    w_in = w_in.at[:, :, 3 * ATT_WIDTH:3 * ATT_WIDTH + N_HEADS].multiply(FORGET_W_SCALE)
    w_pool = nrm(ks[10], (DEPTH, N_POOL_GROUPS, POOL_GROUP_DIM, POOL_GROUP_DIM)) * POOL_GROUP_DIM ** -0.5
    pool_scale = 1.0 + 0.1 * nrm(ks[11], (DEPTH, POOL_WIDTH))
    w_out = nrm(ks[12], (DEPTH, MIX_WIDTH, D_MODEL)) * (MIX_WIDTH ** -0.5) * BETA
    ln1_g = 1.0 + 0.05 * nrm(ks[13], (DEPTH, D_MODEL))
    ln1_b = 0.02 * nrm(ks[14], (DEPTH, D_MODEL))
    w_up = nrm(ks[15], (DEPTH, D_MODEL, 2 * D_FF)) * D_MODEL ** -0.5
    b_up = 0.02 * nrm(ks[16], (DEPTH, 2 * D_FF))
    w_conv = nrm(ks[17], (DEPTH, CONV_WIDTH, 2 * D_FF)) * CONV_WIDTH ** -0.5
    b_conv = 0.02 * nrm(ks[18], (DEPTH, 2 * D_FF))
    w_down = nrm(ks[19], (DEPTH, D_FF, D_MODEL)) * (D_FF ** -0.5) * BETA
    ln2_g = 1.0 + 0.05 * nrm(ks[20], (DEPTH, D_MODEL))
    ln2_b = 0.02 * nrm(ks[21], (DEPTH, D_MODEL))
    return {"x_prompt": x_prompt, "x_sample": x_sample,
            "cache_k": cache_k, "cache_v": cache_v, "cache_logf": cache_logf,
            "state_pool": state_pool, "state_conv": state_conv, "page_table": page_table,
            "w_in": w_in, "b_f": b_f, "w_pool": w_pool, "pool_scale": pool_scale,
            "w_out": w_out, "ln1_g": ln1_g, "ln1_b": ln1_b,
            "w_up": w_up, "b_up": b_up, "w_conv": w_conv, "b_conv": b_conv,
            "w_down": w_down, "ln2_g": ln2_g, "ln2_b": ln2_b}


def reference(x_prompt, x_sample, cache_k, cache_v, cache_logf, state_pool, state_conv,
              page_table, w_in, b_f, w_pool, pool_scale, w_out, ln1_g, ln1_b,
              w_up, b_up, w_conv, b_conv, w_down, ln2_g, ln2_b):
    B, T_p = x_prompt.shape[0], x_prompt.shape[1]
    DB, T_s = x_sample.shape[0], x_sample.shape[1]
    n_pages = page_table.shape[1]
    n_past = n_pages * PAGE_SIZE
    pos_p = jnp.arange(T_p, dtype=jnp.int32)
    pos_s = n_past + jnp.arange(T_s, dtype=jnp.int32)
    empty_kv = jnp.zeros((B, 0, N_HEADS, HEAD_DIM), x_prompt.dtype)
    empty_kc = jnp.zeros((B, 0, N_HEADS), jnp.float32)
    zero_pool = jnp.zeros((B, MAX_WINDOW - 1, POOL_WIDTH), x_prompt.dtype)
    zero_conv = jnp.zeros((B, CONV_WIDTH - 1, 2 * D_FF), x_prompt.dtype)
    yp, ys = x_prompt, x_sample
    kp_l, vp_l, fp_l, pp_l, cp_l = [], [], [], [], []
    ks_l, vs_l, fs_l, ps_l, cs_l = [], [], [], [], []
    for l in range(DEPTH):
        weights = (w_in[l], b_f[l], w_pool[l], pool_scale[l], w_out[l], ln1_g[l], ln1_b[l],
                   w_up[l], b_up[l], w_conv[l], b_conv[l], w_down[l], ln2_g[l], ln2_b[l])
        yp, kp, vp, fp, pp, cp = _layer(yp, pos_p, empty_kv, empty_kv, empty_kc,
                                        zero_pool, zero_conv, *weights)
        k_past = cache_k[l][page_table].reshape(DB, n_past, N_HEADS, HEAD_DIM)
        v_past = cache_v[l][page_table].reshape(DB, n_past, N_HEADS, HEAD_DIM)
        lf_past = cache_logf[l][page_table].reshape(DB, n_past, N_HEADS).astype(jnp.float32)
        kc_past = lf_past - lax.cumsum(lf_past, axis=1, reverse=True)
        ys, ksn, vsn, fsn, psn, csn = _layer(ys, pos_s, k_past, v_past, kc_past,
                                             state_pool[l], state_conv[l], *weights)
        kp_l.append(kp); vp_l.append(vp); fp_l.append(fp); pp_l.append(pp); cp_l.append(cp)
        ks_l.append(ksn); vs_l.append(vsn); fs_l.append(fsn); ps_l.append(psn); cs_l.append(csn)
    return (yp, ys,
            jnp.stack(kp_l, 0), jnp.stack(vp_l, 0), jnp.stack(fp_l, 0),
            jnp.stack(pp_l, 0), jnp.stack(cp_l, 0),
            jnp.stack(ks_l, 0), jnp.stack(vs_l, 0), jnp.stack(fs_l, 0),
            jnp.stack(ps_l, 0), jnp.stack(cs_l, 0))
```

```cpp
#include <hip/hip_runtime.h>
#include <hip/hip_bf16.h>
#include <cstdio>
#include <cstdint>
#include <cmath>
namespace pg8 {
#define PG8_LAS __attribute__((address_space(3)))
typedef unsigned short bf16_t;
typedef short bf16x8 __attribute__((ext_vector_type(8)));
typedef float f32x4 __attribute__((ext_vector_type(4)));
typedef unsigned u32x4 __attribute__((ext_vector_type(4)));
constexpr int BM = 256, BK = 64, HALF = 128, HTB = HALF * BK * 2  , STAGE_BYTES = 8 * HTB, NXCD = 8, WGM = 8;

__host__ __device__ __forceinline__ int lds_byte(int r, int c) { const int st = (r >> 4) * 2 + (c >> 5), rr = r & 15, cc = c & 31, ob = rr * 64 + cc * 2; return st * 1024 + (ob ^ (((ob >> 9) & 1) << 5)); }
__host__ __device__ __forceinline__ void stage_rc(int b, int& R, int& C) { const int st = b / 1024, sb = b % 1024, swz = sb ^ (((sb >> 9) & 1) << 5); R = (st >> 1) * 16 + swz / 64; C = (st & 1) * 32 + (swz % 64) / 2; }
__host__ __device__ __forceinline__ int perm32(int rho) { const int n = rho >> 4, i = rho & 15; return 8 * (i >> 2) + 4 * n + (i & 3); }

struct Unit { int pm, pn; };
struct Gemm { const bf16_t* A; const bf16_t* Bt; int M, N, K; };

struct StaticOrder {
    int nM, nN, nwg, G, c;
    __host__ __device__ void init(int M, int N, int G_, int c_) { nM = M / BM; nN = N / BM; nwg = nM * nN; G = G_; c = c_; }
    __host__ __device__ bool next(int i, Unit& u) const {
        const long L = (long)i * G + c; if (L >= nwg) return false;
        int wgid = (int)L; { const int q = nwg / NXCD, r = nwg % NXCD, xcd = wgid % NXCD, off = wgid / NXCD; wgid = (xcd < r ? xcd * (q + 1) : r * (q + 1) + (xcd - r) * q) + off; }
        const int nig = WGM * nN, gid = wgid / nig, fm = gid * WGM, gsz = (nM - fm) < WGM ? (nM - fm) : WGM;
        u.pm = fm + ((wgid % nig) % gsz); u.pn = (wgid % nig) / gsz; return true;
    }
    __device__ __forceinline__ void a_ready(const Unit&) const {}
    __device__ __forceinline__ void done(const Unit&) const {}
};

__device__ __forceinline__ unsigned cvt_pk_bf16(float lo, float hi) { unsigned r; asm volatile("v_cvt_pk_bf16_f32 %0, %1, %2" : "=v"(r) : "v"(lo), "v"(hi)); return r; }
typedef float f32x2 __attribute__((ext_vector_type(2)));
__device__ __forceinline__ f32x2 gelu_pk(f32x2 v) {
    const f32x2 av = __builtin_elementwise_abs(v), d = av * 0.2316418882f + 1.0f;
    f32x2 t; t.x = __builtin_amdgcn_rcpf(d.x); t.y = __builtin_amdgcn_rcpf(d.y);
    f32x2 q = t * 0.5307027145f + (-0.7265760135f); q = q * t + 0.7107068705f; q = q * t + (-0.142248368f); q = q * t + 0.127414796f; q = q * t;
    const f32x2 s = (v * v) * (-0.72134752044f);
    f32x2 e; e.x = __builtin_amdgcn_exp2f(s.x); e.y = __builtin_amdgcn_exp2f(s.y);
    const f32x2 m = v * (q * e), r = v - m;
    f32x2 o; o.x = v.x < 0.f ? m.x : r.x; o.y = v.y < 0.f ? m.y : r.y; return o;
}

template <int ACT  > struct EpiBf16 {
    static constexpr bool PERM = true, AFTER_DRAIN = false; static_assert(ACT == 0 || ACT == 1, "EpiBf16: ACT is 0 (none) or 1 (gelu_pk)");
    bf16_t* O; int ldc; const float* bias; int split_cols; size_t split_stride; float scale0;
    __device__ __forceinline__ void operator()(const f32x4 (&acc)[2][2][4][2], const Unit& u, int wr, int wc, int fr, int fq) const {
        const int row0 = u.pm * BM + wr * 64 + fr; int colt = u.pn * BM; bf16_t* base = O;
        float sc = 1.f; if (split_cols) { const int t = colt / split_cols; base += (size_t)t * split_stride; colt -= t * split_cols; if (t == 0) sc = scale0; }
        const int col0 = colt + wc * 32 + 8 * fq, bcol0 = u.pn * BM + wc * 32 + 8 * fq;
        f32x4 bv[2][2];
#pragma unroll
        for (int bj = 0; bj < 2; ++bj)
#pragma unroll
            for (int n = 0; n < 2; ++n) bv[bj][n] = bias ? *(const f32x4*)(bias + bcol0 + bj * HALF + 4 * n) : (f32x4){0.f, 0.f, 0.f, 0.f};
#pragma unroll
        for (int ai = 0; ai < 2; ++ai)
#pragma unroll
            for (int m = 0; m < 4; ++m) { bf16_t* rowp = base + (size_t)(row0 + ai * HALF + m * 16) * ldc + col0;
#pragma unroll
                for (int bj = 0; bj < 2; ++bj) { f32x4 v0 = acc[ai][bj][m][0] + bv[bj][0], v1 = acc[ai][bj][m][1] + bv[bj][1];
                    if (ACT == 1) { f32x2 a = gelu_pk((f32x2){v0[0], v0[1]}), b = gelu_pk((f32x2){v0[2], v0[3]}), c = gelu_pk((f32x2){v1[0], v1[1]}), d = gelu_pk((f32x2){v1[2], v1[3]});
                        v0 = (f32x4){a.x, a.y, b.x, b.y}; v1 = (f32x4){c.x, c.y, d.x, d.y}; }
                    v0 = v0 * sc; v1 = v1 * sc; u32x4 w; w.x = cvt_pk_bf16(v0[0], v0[1]); w.y = cvt_pk_bf16(v0[2], v0[3]); w.z = cvt_pk_bf16(v1[0], v1[1]); w.w = cvt_pk_bf16(v1[2], v1[3]);
                    *(u32x4*)(rowp + bj * HALF) = w; } }
    }
};

struct EpiWin {
    static constexpr bool PERM = true, AFTER_DRAIN = false;
    bf16_t* O; float* kP; float* kS; float* poolP; float* poolS; float qscale;
    __device__ __forceinline__ void operator()(const f32x4 (&acc)[2][2][4][2], const Unit& u, int wr, int wc, int fr, int fq) const {
        const int row0 = u.pm * BM + wr * 64 + fr, col0 = u.pn * BM + wc * 32 + 8 * fq, kind = u.pn >> 1;
        const bool samp = u.pm >= 64; const float sc = kind == 0 ? qscale : 1.f;
        float* kvdst = (samp ? kS : kP) + (size_t)(kind - 1) * (samp ? 256 * 512 : 16384 * 512);
#pragma unroll
        for (int ai = 0; ai < 2; ++ai)
#pragma unroll
            for (int m = 0; m < 4; ++m) { const int row = row0 + ai * HALF + m * 16;
#pragma unroll
                for (int bj = 0; bj < 2; ++bj) { const int col = col0 + bj * HALF; const f32x4 a0 = acc[ai][bj][m][0], a1 = acc[ai][bj][m][1];
                    const f32x4 v0 = a0 * sc, v1 = a1 * sc; u32x4 w; w.x = cvt_pk_bf16(v0[0], v0[1]); w.y = cvt_pk_bf16(v0[2], v0[3]); w.z = cvt_pk_bf16(v1[0], v1[1]); w.w = cvt_pk_bf16(v1[2], v1[3]);
                    *(u32x4*)(O + (size_t)row * 2048 + col) = w;
                    if (kind == 1 || kind == 2) { float* d = kvdst + (size_t)(samp ? row - 16384 : row) * 512 + (col - kind * 512); *(f32x4*)d = a0; *(f32x4*)(d + 4) = a1; }
                    if (kind == 3) { const int c = col - 1536;
                        if (!samp) { const int t = row & 2047; if (t >= 2033) { float* d = poolP + ((size_t)(row >> 11) * 15 + (t - 2033)) * 512 + c; *(f32x4*)d = a0; *(f32x4*)(d + 4) = a1; } }
                        else { const int r = row - 16384; float* d = poolS + ((size_t)(r >> 3) * 15 + 7 + (r & 7)) * 512 + c; *(f32x4*)d = a0; *(f32x4*)(d + 4) = a1; } }
                } }
    }
};
struct EpiF32 {
    static constexpr bool PERM = true, AFTER_DRAIN = false;
    float* O; int ldc;
    __device__ __forceinline__ void operator()(const f32x4 (&acc)[2][2][4][2], const Unit& u, int wr, int wc, int fr, int fq) const {
        const int row0 = u.pm * BM + wr * 64 + fr, col0 = u.pn * BM + wc * 32 + 8 * fq;
#pragma unroll
        for (int ai = 0; ai < 2; ++ai)
#pragma unroll
            for (int m = 0; m < 4; ++m) { float* rowp = O + (size_t)(row0 + ai * HALF + m * 16) * ldc + col0;
#pragma unroll
                for (int bj = 0; bj < 2; ++bj) { *(f32x4*)(rowp + bj * HALF) = acc[ai][bj][m][0]; *(f32x4*)(rowp + bj * HALF + 4) = acc[ai][bj][m][1]; } }
    }
};
struct EpiUp {
    static constexpr bool PERM = true, AFTER_DRAIN = false;
    bf16_t* O; const float* bias; float* convP; float* convS;
    __device__ __forceinline__ void operator()(const f32x4 (&acc)[2][2][4][2], const Unit& u, int wr, int wc, int fr, int fq) const {
        const int row0 = u.pm * BM + wr * 64 + fr, col0 = u.pn * BM + wc * 32 + 8 * fq; const bool samp = u.pm >= 64;
        f32x4 bv[2][2];
#pragma unroll
        for (int bj = 0; bj < 2; ++bj)
#pragma unroll
            for (int n = 0; n < 2; ++n) bv[bj][n] = *(const f32x4*)(bias + col0 + bj * HALF + 4 * n);
#pragma unroll
        for (int ai = 0; ai < 2; ++ai)
#pragma unroll
            for (int m = 0; m < 4; ++m) { const int row = row0 + ai * HALF + m * 16;
#pragma unroll
                for (int bj = 0; bj < 2; ++bj) { const int col = col0 + bj * HALF; const f32x4 v0 = acc[ai][bj][m][0] + bv[bj][0], v1 = acc[ai][bj][m][1] + bv[bj][1];
                    u32x4 w; w.x = cvt_pk_bf16(v0[0], v0[1]); w.y = cvt_pk_bf16(v0[2], v0[3]); w.z = cvt_pk_bf16(v1[0], v1[1]); w.w = cvt_pk_bf16(v1[2], v1[3]);
                    *(u32x4*)(O + (size_t)row * 5632 + col) = w;
                    if (!samp) { const int t = row & 2047; if (t >= 2046) { float* d = convP + ((size_t)(row >> 11) * 2 + (t - 2046)) * 5632 + col; *(f32x4*)d = v0; *(f32x4*)(d + 4) = v1; } }
                    else { const int r = row - 16384, t = r & 7; if (t >= 6) { float* d = convS + ((size_t)(r >> 3) * 2 + (t - 6)) * 5632 + col; *(f32x4*)d = v0; *(f32x4*)(d + 4) = v1; } }
                } }
    }
};
template <class Epi, class Sched, bool ALIGN_EPI = false, bool SP2 = false>
__device__ __forceinline__ void gemm_phase(PG8_LAS unsigned char* lds, const Gemm g, const Sched& S, const Epi& E) {
    int tid_ = threadIdx.x; asm volatile("" : "+v"(tid_));
    const int tid = tid_, wid = __builtin_amdgcn_readfirstlane(tid >> 6), lane = tid & 63, wr = wid >> 2, wc = wid & 3, fr = lane & 15, fq = lane >> 4;
    const int K = g.K, nt = K / BK;
    unsigned voffA[2], voffB[2];
#pragma unroll
    for (int i = 0; i < 2; ++i) { int R, C; stage_rc(tid * 16 + i * 8192, R, C); const int Rb = Epi::PERM ? ((R & ~31) + perm32(R & 31)) : R;
        voffA[i] = (unsigned)(R * K + C) * 2u; voffB[i] = (unsigned)(Rb * K + C) * 2u; }
    const size_t kstep = (size_t)(BK * 2);
    const size_t hstep = (size_t)HALF * K * 2;
    const size_t tstep = 2 * hstep;
    const unsigned ldsw = (unsigned)wid * 1024u;
    const int aoff = lds_byte(wr * 64 + fr, fq * 8), boff = lds_byte(wc * 32 + fr, fq * 8);
#define PG8_SA(b, h) (((b) * 2 + (h)) * HTB)
#define PG8_SB(b, h) ((4 + (b) * 2 + (h)) * HTB)
#define PG8_STAGE(bufoff, gbase, voff) do { _Pragma("unroll") for (int _i = 0; _i < 2; ++_i) \
        __builtin_amdgcn_global_load_lds((const unsigned*)((const char*)(gbase) + (voff)[_i]), (PG8_LAS unsigned*)(lds + (bufoff) + ldsw + _i * 8192), 16, 0, 0); } while (0)
#define PG8_LDA(dst, b, h) do { _Pragma("unroll") for (int m = 0; m < 4; ++m) _Pragma("unroll") for (int k = 0; k < 2; ++k) dst[m][k] = *(const PG8_LAS bf16x8*)(lds + PG8_SA(b, h) + aoff + m * 2048 + k * 1024); } while (0)
#define PG8_LDB(dst, b, h) do { _Pragma("unroll") for (int n = 0; n < 2; ++n) _Pragma("unroll") for (int k = 0; k < 2; ++k) dst[n][k] = *(const PG8_LAS bf16x8*)(lds + PG8_SB(b, h) + boff + n * 2048 + k * 1024); } while (0)
#define PG8_MMA(ai, bj, At, Bt) do { __builtin_amdgcn_s_setprio(1); _Pragma("unroll") for (int m = 0; m < 4; ++m) _Pragma("unroll") for (int n = 0; n < 2; ++n) _Pragma("unroll") for (int k = 0; k < 2; ++k) \
        acc[ai][bj][m][n] = __builtin_amdgcn_mfma_f32_16x16x32_bf16(Bt[n][k], At[m][k], acc[ai][bj][m][n], 0, 0, 0); __builtin_amdgcn_s_setprio(0); } while (0)
#define PG8_WAIT_V(n) asm volatile("s_waitcnt vmcnt(" #n ")" ::: "memory")
#define PG8_WAIT_L(n) asm volatile("s_waitcnt lgkmcnt(" #n ")" ::: "memory")
#define PG8_BAR __builtin_amdgcn_s_barrier()
#define PG8_SCHED __builtin_amdgcn_sched_barrier(0)
    Unit cur, nxt; int ui = 0;
    if (!S.next(0, cur)) return;
    f32x4 acc[2][2][4][2];
#pragma unroll
    for (int a = 0; a < 2; ++a)
#pragma unroll
        for (int b = 0; b < 2; ++b)
#pragma unroll
            for (int m = 0; m < 4; ++m)
#pragma unroll
                for (int n = 0; n < 2; ++n) acc[a][b][m][n] = (f32x4){0.f, 0.f, 0.f, 0.f};
    bf16x8 At[4][2], B0[2][2], B1[2][2];
    const char* cA = (const char*)g.A + (size_t)cur.pm * tstep; const char* cB = (const char*)g.Bt + (size_t)cur.pn * tstep;
    S.a_ready(cur);
    if constexpr (SP2) {
        PG8_STAGE(PG8_SB(0, 0), cB, voffB); PG8_STAGE(PG8_SB(0, 1), cB + hstep, voffB); PG8_STAGE(PG8_SA(0, 0), cA, voffA); PG8_STAGE(PG8_SA(0, 1), cA + hstep, voffA);
        if (wr == 1) PG8_BAR;
        PG8_WAIT_V(2); PG8_BAR;
        PG8_STAGE(PG8_SB(1, 0), cB + kstep, voffB); PG8_STAGE(PG8_SA(1, 0), cA + kstep, voffA); PG8_STAGE(PG8_SB(1, 1), cB + hstep + kstep, voffB);
        PG8_WAIT_V(6); PG8_BAR;
    } else {
        PG8_STAGE(PG8_SB(0, 0), cB, voffB); PG8_STAGE(PG8_SA(0, 0), cA, voffA); PG8_STAGE(PG8_SB(0, 1), cB + hstep, voffB); PG8_STAGE(PG8_SA(0, 1), cA + hstep, voffA);
        if (wr == 1) PG8_BAR;
        PG8_WAIT_V(4); PG8_BAR;
        PG8_STAGE(PG8_SB(1, 0), cB + kstep, voffB); PG8_STAGE(PG8_SA(1, 0), cA + kstep, voffA); PG8_STAGE(PG8_SB(1, 1), cB + hstep + kstep, voffB);
        PG8_WAIT_V(6); PG8_BAR;
    }
    for (;;) {
        const bool has_next = S.next(ui + 1, nxt);
        const char* nA = has_next ? (const char*)g.A + (size_t)nxt.pm * tstep : cA; const char* nB = has_next ? (const char*)g.Bt + (size_t)nxt.pn * tstep : cB;
        for (int t = 0; t < nt; t += 2) {
            const bool last = (t == nt - 2);
            const char* a1 = cA + (size_t)(t + 1) * kstep;
            const char* a2 = last ? nA : cA + (size_t)(t + 2) * kstep; const char* b2 = last ? nB : cB + (size_t)(t + 2) * kstep;
            const char* a3 = a2 + kstep; const char* b3 = b2 + kstep;
            if (last && has_next) S.a_ready(nxt);
            if constexpr (SP2) {
            PG8_LDB(B0, 0, 0); PG8_LDB(B1, 0, 1); PG8_SCHED; PG8_LDA(At, 0, 0); PG8_STAGE(PG8_SA(1, 1), a1 + hstep, voffA);
            PG8_WAIT_V(8); PG8_WAIT_L(0); PG8_BAR; PG8_MMA(0, 0, At, B0); PG8_MMA(0, 1, At, B1); PG8_BAR; PG8_SCHED;
            PG8_LDA(At, 0, 1); PG8_STAGE(PG8_SB(0, 0), b2, voffB); PG8_STAGE(PG8_SB(0, 1), b2 + hstep, voffB); PG8_STAGE(PG8_SA(0, 0), a2, voffA);
            PG8_WAIT_V(8); PG8_WAIT_L(0); PG8_BAR; PG8_MMA(1, 0, At, B0); PG8_MMA(1, 1, At, B1); PG8_BAR; PG8_SCHED;
            PG8_LDB(B0, 1, 0); PG8_LDB(B1, 1, 1); PG8_SCHED; PG8_LDA(At, 1, 0); PG8_STAGE(PG8_SA(0, 1), a2 + hstep, voffA);
            PG8_WAIT_V(8); PG8_WAIT_L(0); PG8_BAR; PG8_MMA(0, 0, At, B0); PG8_MMA(0, 1, At, B1); PG8_BAR; PG8_SCHED;
            PG8_LDA(At, 1, 1); PG8_STAGE(PG8_SB(1, 0), b3, voffB); PG8_STAGE(PG8_SB(1, 1), b3 + hstep, voffB); PG8_STAGE(PG8_SA(1, 0), a3, voffA);
            PG8_WAIT_V(8); PG8_WAIT_L(0); PG8_BAR; PG8_MMA(1, 0, At, B0); PG8_MMA(1, 1, At, B1); PG8_BAR; PG8_SCHED;
            } else {
            PG8_LDB(B0, 0, 0); PG8_SCHED; PG8_LDA(At, 0, 0); PG8_STAGE(PG8_SA(1, 1), a1 + hstep, voffA);
            PG8_WAIT_L(8); PG8_BAR; PG8_WAIT_L(0); PG8_MMA(0, 0, At, B0); PG8_BAR; PG8_SCHED;
            PG8_LDB(B1, 0, 1); PG8_STAGE(PG8_SB(0, 0), b2, voffB);
            PG8_BAR; PG8_WAIT_L(0); PG8_MMA(0, 1, At, B1); PG8_BAR;
            PG8_LDA(At, 0, 1); PG8_STAGE(PG8_SA(0, 0), a2, voffA);
            PG8_BAR; PG8_WAIT_L(0); PG8_MMA(1, 0, At, B0); PG8_BAR; PG8_SCHED;
            PG8_STAGE(PG8_SB(0, 1), b2 + hstep, voffB);
            PG8_WAIT_V(6); PG8_BAR; PG8_MMA(1, 1, At, B1); PG8_BAR;
            PG8_LDB(B0, 1, 0); PG8_SCHED; PG8_LDA(At, 1, 0); PG8_STAGE(PG8_SA(0, 1), a2 + hstep, voffA);
            PG8_WAIT_L(8); PG8_BAR; PG8_WAIT_L(0); PG8_MMA(0, 0, At, B0); PG8_BAR; PG8_SCHED;
            PG8_LDB(B1, 1, 1); PG8_STAGE(PG8_SB(1, 0), b3, voffB);
            PG8_BAR; PG8_WAIT_L(0); PG8_MMA(0, 1, At, B1); PG8_BAR;
            PG8_LDA(At, 1, 1); PG8_STAGE(PG8_SA(1, 0), a3, voffA);
            PG8_BAR; PG8_WAIT_L(0); PG8_MMA(1, 0, At, B0); PG8_BAR; PG8_SCHED;
            PG8_STAGE(PG8_SB(1, 1), b3 + hstep, voffB);
            PG8_WAIT_V(6); PG8_BAR; PG8_MMA(1, 1, At, B1); PG8_BAR;
            }
        }
        if constexpr (ALIGN_EPI) { if (wr == 0) PG8_BAR; }
        if constexpr (!Epi::AFTER_DRAIN) { E(acc, cur, wr, wc, fr, fq); S.done(cur); }
        if (!has_next) break;
#pragma unroll
        for (int a = 0; a < 2; ++a)
#pragma unroll
            for (int b = 0; b < 2; ++b)
#pragma unroll
                for (int m = 0; m < 4; ++m)
#pragma unroll
                    for (int n = 0; n < 2; ++n) acc[a][b][m][n] = (f32x4){0.f, 0.f, 0.f, 0.f};
        cur = nxt; cA = nA; cB = nB; ++ui;
        if constexpr (ALIGN_EPI) { if (wr == 1) PG8_BAR; }
    }
    PG8_WAIT_V(0);
    if constexpr (!ALIGN_EPI) { if (wr == 0) PG8_BAR; }
    PG8_BAR;
    if constexpr (Epi::AFTER_DRAIN) { E.fused(acc, cur, wr, wc, fr, fq, lds, wid, lane); S.done(cur); }
#undef PG8_SA
#undef PG8_SB
#undef PG8_STAGE
#undef PG8_LDA
#undef PG8_LDB
#undef PG8_MMA
#undef PG8_WAIT_V
#undef PG8_WAIT_L
#undef PG8_BAR
#undef PG8_SCHED
}
}
#ifndef PG8_SP2
#define PG8_SP2 true
#endif
#ifndef PG8_ALIGN
#define PG8_ALIGN true
#endif
#include <hip/hip_bf16.h>
#include <cmath>
namespace attn_body {
using bf16=__hip_bfloat16;
using bf16x8=__attribute__((ext_vector_type(8)))short;
using s16x4=__attribute__((ext_vector_type(4)))short;
using f32x16=__attribute__((ext_vector_type(16)))float;
using u32x4=__attribute__((ext_vector_type(4)))unsigned;
constexpr int BATCH=8,NHEAD=8,SEQ=2048,D=64,DM=2048,DMO=1024;
constexpr int NW=8,QBLK=32,QB=QBLK*NW,KVBLK=64,NQB=SEQ/QB;
constexpr int ATTN_PITCH=DM, ATTN_UNIT_ROWS=QB;
__device__ __forceinline__ int crow(int r,int hi){return (r&3)+8*(r>>2)+4*hi;}
#define SBAR() __builtin_amdgcn_sched_barrier(0)
__device__ __forceinline__ void cmask(f32x16&p0,f32x16&p1,int jb,int qrel,int hi){
  const float NEG=-INFINITY; int kb=64*jb+4*hi;
  #pragma unroll
  for(int r=0;r<16;++r){int kv=kb+(r&3)+8*(r>>2); if(kv>qrel)p0[r]=NEG; if(kv+32>qrel)p1[r]=NEG;}
}

constexpr int NSLOT=3, SLOTB=8192;
constexpr int LDS_K=0, LDS_V=NSLOT*SLOTB, LDS_WS=2*NSLOT*SLOTB, LDS_OST=LDS_WS+NW*64*4, LDS_TAB=LDS_OST+NW*4096, LDS_BYTES=LDS_TAB+SEQ*16;
constexpr float C2=0.125f*1.4426950408889634f;
__device__ __forceinline__ void glds16(const void*gsrc,unsigned lds_dst){unsigned keep;
  asm volatile("s_mov_b32 %0, m0\n\ts_mov_b32 m0, %2\n\ts_nop 0\n\tglobal_load_lds_dwordx4 %1, off\n\ts_mov_b32 m0, %0":"=&s"(keep):"v"(gsrc),"s"(lds_dst):"memory");}
__device__ __forceinline__ float max3f(float a,float b,float c){float r;asm("v_max3_f32 %0, %1, %2, %3":"=v"(r):"v"(a),"v"(b),"v"(c));return r;}
__device__ __forceinline__ float max2f(float a,float b){float r;asm("v_max_f32_e32 %0, %1, %2":"=v"(r):"v"(a),"v"(b));return r;}
__device__ __forceinline__ float fadd_s(float a,float b){float r;asm("v_add_f32_e32 %0, %1, %2":"=v"(r):"v"(a),"v"(b));return r;}
__device__ __forceinline__ float fsub_s(float a,float b){float r;asm("v_sub_f32_e32 %0, %1, %2":"=v"(r):"v"(a),"v"(b));return r;}
typedef float f32x2_t __attribute__((ext_vector_type(2))); typedef __bf16 bf16x2_t __attribute__((ext_vector_type(2)));
__device__ __forceinline__ unsigned cvtpk_s(float lo,float hi){f32x2_t v={lo,hi};bf16x2_t b=__builtin_convertvector(v,bf16x2_t);return __builtin_bit_cast(unsigned,b);}
#define WAIT_BAR(N) asm volatile("s_waitcnt vmcnt(" #N ") lgkmcnt(0)\n\ts_barrier":::"memory")

__device__ __forceinline__ void qkt(f32x16&p0,f32x16&p1,const char*Kslot,const bf16x8*qr,int r32,int hi){ const f32x16 negm=f32x16{};
  const char*kb=Kslot+hi*1024+r32*16;
  #pragma unroll
  for(int d0=0;d0<4;++d0){
    const bf16x8 b0=*reinterpret_cast<const bf16x8*>(kb+d0*2048);
    const bf16x8 b1=*reinterpret_cast<const bf16x8*>(kb+d0*2048+512);
    if(d0==0){p0=__builtin_amdgcn_mfma_f32_32x32x16_bf16(b0,qr[0],negm,0,0,0);p1=__builtin_amdgcn_mfma_f32_32x32x16_bf16(b1,qr[0],negm,0,0,0);}
    else{p0=__builtin_amdgcn_mfma_f32_32x32x16_bf16(b0,qr[d0],p0,0,0,0);p1=__builtin_amdgcn_mfma_f32_32x32x16_bf16(b1,qr[d0],p1,0,0,0);}}
}
typedef __attribute__((address_space(3))) const char* lds_cptr;
typedef short v4i16_t __attribute__((ext_vector_type(4)));
__device__ __forceinline__ void kload8(bf16x8*kf,lds_cptr kp){
  kf[0]=*(const __attribute__((address_space(3))) bf16x8*)(kp);      kf[1]=*(const __attribute__((address_space(3))) bf16x8*)(kp+512);
  kf[2]=*(const __attribute__((address_space(3))) bf16x8*)(kp+2048); kf[3]=*(const __attribute__((address_space(3))) bf16x8*)(kp+2560);
  kf[4]=*(const __attribute__((address_space(3))) bf16x8*)(kp+4096); kf[5]=*(const __attribute__((address_space(3))) bf16x8*)(kp+4608);
  kf[6]=*(const __attribute__((address_space(3))) bf16x8*)(kp+6144); kf[7]=*(const __attribute__((address_space(3))) bf16x8*)(kp+6656);
}
__device__ __forceinline__ void kload2(bf16x8*kf,lds_cptr kp,int j){ kf[2*j]=*(const __attribute__((address_space(3))) bf16x8*)(kp+j*2048); kf[2*j+1]=*(const __attribute__((address_space(3))) bf16x8*)(kp+j*2048+512); }
__device__ __forceinline__ s16x4 vtr(lds_cptr p){ return __builtin_bit_cast(s16x4,__builtin_amdgcn_ds_read_tr16_b64_v4i16((__attribute__((address_space(3))) v4i16_t*)p)); }
__device__ __forceinline__ float rowmax(const f32x16&p0,const f32x16&p1){
  float a=max3f(p0[0],p0[1],p1[0]),b=max3f(p0[2],p0[3],p1[1]);a=max3f(a,p1[2],p1[3]);
  #pragma unroll
  for(int r=4;r<16;r+=4){a=max3f(a,p0[r],p0[r+1]);b=max3f(b,p0[r+2],p0[r+3]);a=max3f(a,p1[r],p1[r+1]);b=max3f(b,p1[r+2],p1[r+3]);}
  const float m=max2f(a,b);
  auto rr=__builtin_amdgcn_permlane32_swap(__float_as_uint(m),__float_as_uint(m),false,false);
  return max2f(__uint_as_float(rr[0]),__uint_as_float(rr[1]));
}
__device__ __forceinline__ void pv(f32x16*o,int vb,bf16x8 pa0,bf16x8 pa1,bf16x8 pa2,bf16x8 pa3){
  #pragma unroll
  for(int d0=0;d0<2;++d0){s16x4 lo[4],hi[4];
    #pragma unroll
    for(int ks=0;ks<4;++ks){
      asm volatile("ds_read_b64_tr_b16 %0,%1 offset:%c2":"=&v"(lo[ks]):"v"(vb),"i"(d0*4096+ks*1024):"memory");
      asm volatile("ds_read_b64_tr_b16 %0,%1 offset:%c2":"=&v"(hi[ks]):"v"(vb),"i"(d0*4096+ks*1024+512):"memory");}
    asm volatile("s_waitcnt lgkmcnt(0)":::"memory");SBAR();
    #define PK(k) (bf16x8){lo[k][0],lo[k][1],lo[k][2],lo[k][3],hi[k][0],hi[k][1],hi[k][2],hi[k][3]}
    o[d0]=__builtin_amdgcn_mfma_f32_32x32x16_bf16(pa0,PK(0),o[d0],0,0,0);
    o[d0]=__builtin_amdgcn_mfma_f32_32x32x16_bf16(pa1,PK(1),o[d0],0,0,0);
    o[d0]=__builtin_amdgcn_mfma_f32_32x32x16_bf16(pa2,PK(2),o[d0],0,0,0);
    o[d0]=__builtin_amdgcn_mfma_f32_32x32x16_bf16(pa3,PK(3),o[d0],0,0,0);
    #undef PK
  }
}

#ifndef ATTN_STORE16
#define ATTN_STORE16(p,v) (*(u32x4*)(p)=(v))
#endif
template<int THRL> __device__ __forceinline__ void attn_unit(int b,int h,int qb,const bf16*Q,const bf16*__restrict__ K,const bf16*__restrict__ V,bf16*O,const uint2*__restrict__ AUG,char*shm){
  int tid_=threadIdx.x; asm volatile("":"+v"(tid_)); const int tid=tid_,lane=tid&63,r32=lane&31,hi=lane>>5; const int wid=__builtin_amdgcn_readfirstlane(tid>>6);
  const long rowbase=(long)b*SEQ; const int q0=qb*QB;
  const bf16*Qw=Q+(rowbase+q0+wid*QBLK)*DM+h*D;
  const bf16*Kh=K+rowbase*DM+h*D,*Vh=V+rowbase*DM+h*D;
  const lds_cptr shm3=(lds_cptr)shm;
  const unsigned lds0=(unsigned)(uintptr_t)shm;
  float*wsf=(float*)(shm+LDS_WS)+wid*64;
  const bf16*ksrc=Kh+(long)lane*DM+wid*8;
  const bf16*vsrc=Vh+(long)(16*(wid&3)+(lane>>2))*DM+(wid>>2)*32+(lane&3)*8;
  const unsigned kdst=lds0+LDS_K+wid*1024, vdst=lds0+LDS_V+wid*1024;
  #define DMA_K(t,slot) glds16(ksrc+(long)(t)*KVBLK*DM,(unsigned)__builtin_amdgcn_readfirstlane(kdst+(slot)))
  #define DMA_V(t,slot) glds16(vsrc+(long)(t)*KVBLK*DM,(unsigned)__builtin_amdgcn_readfirstlane(vdst+(slot)))
  const int vb0=(int)(lds0+LDS_V)+((lane>>4)&1)*32+(lane&3)*8+(4*hi+((lane&15)>>2))*64;
  const char*Kbase=shm+LDS_K; bf16x8 kf[8];
  const lds_cptr kp0=shm3+LDS_K+hi*1024+r32*16; const lds_cptr vp0=shm3+LDS_V+((lane>>4)&1)*32+(lane&3)*8+(4*hi+((lane&15)>>2))*64;
  const int NT=(q0+QB)/KVBLK;
  { const __attribute__((address_space(1))) unsigned long long*ag=(const __attribute__((address_space(1))) unsigned long long*)(AUG+(long)(b*NHEAD+h)*SEQ); __attribute__((address_space(3))) unsigned long long*tab=(__attribute__((address_space(3))) unsigned long long*)(shm3+LDS_TAB); const int nk=q0+QB;
    for(int k=tid;k<nk;k+=NW*64){ const unsigned long long e=ag[k]; tab[2*k]=(e&0x0000ffffffffffffull)|0x3F80000000000000ull; tab[2*k+1]=0x000000003F803F80ull; } }
  const lds_cptr tabp=shm3+LDS_TAB+r32*16+hi*8;
  s16x4 qaug;
  #define SETQAUG() do{ const float nm_=-mhat; const unsigned h0_=cvtpk_s(nm_,0.f)&0xffffu; const float r1_=nm_-__uint_as_float(h0_<<16); const unsigned h1_=cvtpk_s(r1_,0.f)&0xffffu; const float r2_=r1_-__uint_as_float(h1_<<16); const unsigned h2_=cvtpk_s(r2_,0.f)&0xffffu; \
    const unsigned w0_=hi?(h1_|(h2_<<16)):0x3F803F80u, w1_=hi?0u:(0x3F80u|(h0_<<16)); qaug=__builtin_bit_cast(s16x4,(unsigned long long)w0_|((unsigned long long)w1_<<32)); asm volatile("":"+v"(qaug)); }while(0)
  #define KAUG(off) (*(const __attribute__((address_space(3))) s16x4*)(tabp+(off)))
  #define MFA(a,c) __builtin_amdgcn_mfma_f32_32x32x8bf16_1k((a),qaug,(c),0,0,0)
  DMA_K(0,0);DMA_V(0,0);DMA_K(1,SLOTB);
  bf16x8 qr[4];
  #pragma unroll
  for(int d0=0;d0<4;++d0)qr[d0]=*reinterpret_cast<const bf16x8*>(&Qw[(long)r32*DM+d0*16+hi*8]);
  float mhat=0.f,l_reg=0.f;f32x16 o[2];o[0]=f32x16{};o[1]=f32x16{}; SETQAUG();
  const int qrel=wid*QBLK+r32;
  #define CMASK(P0,P1,t) do{int jb_=(t)-(NT-4); if(jb_>=0)cmask(P0,P1,jb_,qrel,hi);}while(0)
  bool resc=false;
  #define START(P0,P1) do{ const float rm=rowmax(P0,P1); resc=false; \
    { const float dl=rm; mhat=fadd_s(mhat,dl); \
      _Pragma("unroll") for(int r=0;r<16;++r){P0[r]=fsub_s(P0[r],dl);P1[r]=fsub_s(P1[r],dl);} \
      SETQAUG(); } \
    _Pragma("unroll") for(int r=0;r<16;++r)P0[r]=__builtin_amdgcn_exp2f(P0[r]); }while(0)
  #define RESC() do{ if(resc){ asm volatile("s_waitcnt lgkmcnt(0)":::"memory"); \
      _Pragma("unroll") for(int d_=0;d_<2;++d_) _Pragma("unroll") for(int r=0;r<16;++r)o[d_][r]*=wsf[crow(r,hi)]; } }while(0)
  f32x16 pA0,pA1,pB0,pB1;
  int sl_prev=0,sl_cur=0,sl_next=SLOTB;
  #define ROT() do{sl_prev=sl_cur;sl_cur=sl_next;sl_next=(sl_next==(NSLOT-1)*SLOTB)?0:sl_next+SLOTB;}while(0)
  DMA_K(2,2*SLOTB);
  WAIT_BAR(3);
  qkt(pA0,pA1,Kbase,qr,r32,hi);
  pA0=MFA(KAUG(0),pA0); pA1=MFA(KAUG(512),pA1);
  asm volatile("s_nop 15\n\ts_nop 7":"+v"(pA0),"+v"(pA1));CMASK(pA0,pA1,0);
  START(pA0,pA1);
  _Pragma("unroll") for(int r=0;r<16;++r)pA1[r]=__builtin_amdgcn_exp2f(pA1[r]);
  WAIT_BAR(0);
  DMA_K(3,0);DMA_V(1,SLOTB);
  ROT();
  kload8(kf,kp0+sl_cur);
  WAIT_BAR(2);
  s16x4 vlo[8],vhi[8]; u32x4 pw0,pw1,pw2,pw3;
  #define PKW(P,B) cvtpk_s(P[B],P[B+1])
  #define PAF(k) __builtin_bit_cast(bf16x8,pw##k)
  #define VFR(i) (bf16x8){vlo[i][0],vlo[i][1],vlo[i][2],vlo[i][3],vhi[i][0],vhi[i][1],vhi[i][2],vhi[i][3]}
  #define PIN(x) asm volatile("":"+v"(x))
  #define MX3(a,b,c) __builtin_fmaxf(__builtin_fmaxf((a),(b)),(c))
  #define GAPA(MF,A0,A1,A2,A3,W0,W1,PW) do{ MF; sacc+=A0; sacc+=A1; sacc+=A2; sacc+=A3; PIN(sacc); W0; W1; PIN(PW); SBAR(); }while(0)
  #define EX(v) __builtin_amdgcn_exp2f(v)
  #define GAPB(MF,X,B) do{ MF; X[B]=EX(X[B]); X[B+1]=EX(X[B+1]); X[B+2]=EX(X[B+2]); X[B+3]=EX(X[B+3]); PIN(X); SBAR(); }while(0)
  #define VRD(i) do{ vlo[i]=vtr(vp_+(((i)>>2)*4096+((i)&3)*1024)); vhi[i]=vtr(vp_+(((i)>>2)*4096+((i)&3)*1024+512)); }while(0)
  #define KRD(G,j) do{ if(G){ kload2(kf,kp0+sl_next,j); SBAR(); } }while(0)
  #define STEP(C0,C1,P0,P1,t,GK,GV,GL) do{ SBAR(); \
    const lds_cptr vp_=vp0+sl_prev; const s16x4 ka0_=KAUG((t)*1024), ka1_=KAUG((t)*1024+512); \
    VRD(0); SBAR(); float sacc=(P0[0]+P0[1]); \
    GAPA(C0=__builtin_amdgcn_mfma_f32_32x32x16_bf16(kf[0],qr[0],f32x16{},0,0,0), P0[2],P0[3],P0[4],P0[5],     pw0[0]=PKW(P0,0), pw0[1]=PKW(P0,2), pw0); \
    VRD(4); SBAR(); GAPA(C1=__builtin_amdgcn_mfma_f32_32x32x16_bf16(kf[1],qr[0],f32x16{},0,0,0), P0[6],P0[7],P0[8],P0[9],     pw0[2]=PKW(P0,4), pw0[3]=PKW(P0,6), pw0); \
    VRD(1); SBAR(); GAPA(C0=__builtin_amdgcn_mfma_f32_32x32x16_bf16(kf[2],qr[1],C0,0,0,0),   P0[10],P0[11],P0[12],P0[13], pw1[0]=PKW(P0,8), pw1[1]=PKW(P0,10), pw1); \
    VRD(5); SBAR(); GAPA(C1=__builtin_amdgcn_mfma_f32_32x32x16_bf16(kf[3],qr[1],C1,0,0,0),   P0[14],P0[15],P1[0],P1[1],   pw1[2]=PKW(P0,12),pw1[3]=PKW(P0,14), pw1); \
    VRD(2); SBAR(); GAPA(C0=__builtin_amdgcn_mfma_f32_32x32x16_bf16(kf[4],qr[2],C0,0,0,0),   P1[2],P1[3],P1[4],P1[5],     pw2[0]=PKW(P1,0), pw2[1]=PKW(P1,2), pw2); \
    VRD(6); SBAR(); GAPA(C1=__builtin_amdgcn_mfma_f32_32x32x16_bf16(kf[5],qr[2],C1,0,0,0),   P1[6],P1[7],P1[8],P1[9],     pw2[2]=PKW(P1,4), pw2[3]=PKW(P1,6), pw2); \
    VRD(3); SBAR(); GAPA(C0=__builtin_amdgcn_mfma_f32_32x32x16_bf16(kf[6],qr[3],C0,0,0,0),   P1[10],P1[11],P1[12],P1[13], pw3[0]=PKW(P1,8), pw3[1]=PKW(P1,10), pw3); \
    VRD(7); SBAR(); GAPA(C1=__builtin_amdgcn_mfma_f32_32x32x16_bf16(kf[7],qr[3],C1,0,0,0),   P1[14],P1[15],0.f,0.f,       pw3[2]=PKW(P1,12),pw3[3]=PKW(P1,14), pw3); \
    C0=MFA(ka0_,C0); C1=MFA(ka1_,C1); SBAR(); \
    l_reg+=sacc; \
    if(GK){DMA_K((t)+3,sl_cur);} if(GV){DMA_V((t)+1,sl_next);} \
    CMASK(C0,C1,t); \
    { float a=MX3(C0[0],C0[1],C1[0]),b=MX3(C0[2],C0[3],C1[1]); a=MX3(a,C1[2],C1[3]); \
      _Pragma("unroll") for(int r=4;r<16;r+=4){a=MX3(a,C0[r],C0[r+1]);b=MX3(b,C0[r+2],C0[r+3]);a=MX3(a,C1[r],C1[r+1]);b=MX3(b,C1[r+2],C1[r+3]);} \
      float rm=__builtin_fmaxf(a,b); { auto rr=__builtin_amdgcn_permlane32_swap(__float_as_uint(rm),__float_as_uint(rm),false,false); rm=__builtin_fmaxf(__uint_as_float(rr[0]),__uint_as_float(rr[1])); } \
      resc=false; \
      if(__builtin_expect(__any(rm>(float)THRL),0)){ const float dl=__builtin_fmaxf(rm,0.f); mhat+=dl; \
        _Pragma("unroll") for(int r=0;r<16;++r){C0[r]-=dl;C1[r]-=dl;} \
        SETQAUG(); \
        const float f=__builtin_amdgcn_exp2f(-dl); l_reg*=f; if(hi==0)wsf[r32]=f; resc=true; } } \
    SBAR(); \
    GAPB(o[0]=__builtin_amdgcn_mfma_f32_32x32x16_bf16(PAF(0),VFR(0),o[0],0,0,0), C0,0); \
    GAPB(o[1]=__builtin_amdgcn_mfma_f32_32x32x16_bf16(PAF(0),VFR(4),o[1],0,0,0), C0,4); \
    KRD(GL,0); GAPB(o[0]=__builtin_amdgcn_mfma_f32_32x32x16_bf16(PAF(1),VFR(1),o[0],0,0,0), C0,8); \
    KRD(GL,1); GAPB(o[1]=__builtin_amdgcn_mfma_f32_32x32x16_bf16(PAF(1),VFR(5),o[1],0,0,0), C0,12); \
    KRD(GL,2); GAPB(o[0]=__builtin_amdgcn_mfma_f32_32x32x16_bf16(PAF(2),VFR(2),o[0],0,0,0), C1,0); \
    KRD(GL,3); GAPB(o[1]=__builtin_amdgcn_mfma_f32_32x32x16_bf16(PAF(2),VFR(6),o[1],0,0,0), C1,4); \
    GAPB(o[0]=__builtin_amdgcn_mfma_f32_32x32x16_bf16(PAF(3),VFR(3),o[0],0,0,0), C1,8); \
    GAPB(o[1]=__builtin_amdgcn_mfma_f32_32x32x16_bf16(PAF(3),VFR(7),o[1],0,0,0), C1,12); \
    }while(0)
  int t=1;
  #undef CMASK
  #define CMASK(P0,P1,t) do{}while(0)
  for(;t+5<NT;t+=2){
    STEP(pB0,pB1,pA0,pA1,t,true,true,true);     WAIT_BAR(2); RESC(); ROT();
    STEP(pA0,pA1,pB0,pB1,t+1,true,true,true);   WAIT_BAR(2); RESC(); ROT();
  }
  #undef CMASK
  #define CMASK(P0,P1,t) do{int jb_=(t)-(NT-4); if(jb_>=0)cmask(P0,P1,jb_,qrel,hi);}while(0)
  #define ENDW(tt) do{ if((tt)+3<NT){WAIT_BAR(2);} else if((tt)+2<NT){WAIT_BAR(1);} else {WAIT_BAR(0);} }while(0)
  for(;t+1<NT;t+=2){
    STEP(pB0,pB1,pA0,pA1,t,(t+3<NT),(t+1<NT),(t+1<NT));       ENDW(t);   RESC(); ROT();
    STEP(pA0,pA1,pB0,pB1,t+1,(t+4<NT),(t+2<NT),(t+2<NT));     ENDW(t+1); RESC(); ROT();
  }
  STEP(pB0,pB1,pA0,pA1,NT-1,false,false,false); RESC();
  { float sacc=pB0[0]+pB0[1]; _Pragma("unroll") for(int r=2;r<16;++r)sacc+=pB0[r]; _Pragma("unroll") for(int r=0;r<16;++r)sacc+=pB1[r]; l_reg+=sacc;
    pw0=(u32x4){PKW(pB0,0),PKW(pB0,2),PKW(pB0,4),PKW(pB0,6)};pw1=(u32x4){PKW(pB0,8),PKW(pB0,10),PKW(pB0,12),PKW(pB0,14)};pw2=(u32x4){PKW(pB1,0),PKW(pB1,2),PKW(pB1,4),PKW(pB1,6)};pw3=(u32x4){PKW(pB1,8),PKW(pB1,10),PKW(pB1,12),PKW(pB1,14)};
    SBAR(); pv(o,vb0+sl_cur,PAF(0),PAF(1),PAF(2),PAF(3)); }
  #undef PKW
  #undef PAF
  #undef VFR
  #undef PIN
  #undef MX3
  #undef GAPA
  #undef GAPB
  #undef EX
  #undef VRD
  #undef KRD
  #undef STEP
  #undef ENDW
  {auto rr=__builtin_amdgcn_permlane32_swap(__float_as_uint(l_reg),__float_as_uint(l_reg),false,false);l_reg=__uint_as_float(rr[0])+__uint_as_float(rr[1]);}
  if(hi==0)wsf[32+r32]=l_reg;asm volatile("s_waitcnt lgkmcnt(0)":::"memory");
  float rli[16];
  #pragma unroll
  for(int r=0;r<16;++r)rli[r]=__builtin_amdgcn_rcpf(wsf[32+crow(r,hi)]);
  bf16*Ow=O+(rowbase+q0+wid*QBLK)*DMO+h*D;
  { bf16*stg=(bf16*)(shm+LDS_OST)+wid*2048;
    #pragma unroll
    for(int r=0;r<16;++r){const int orow=crow(r,hi);
      #pragma unroll
      for(int d0=0;d0<2;++d0)stg[orow*64+d0*32+r32]=__float2bfloat16(o[d0][r]*rli[r]);}
    asm volatile("s_waitcnt lgkmcnt(0)":::"memory");
    #pragma unroll
    for(int i=0;i<4;++i){const int row=i*8+(lane>>3),ch=lane&7; const u32x4 v=*(const u32x4*)(stg+row*64+ch*8); ATTN_STORE16(Ow+(long)row*DMO+ch*8,v);} }
  asm volatile("s_waitcnt lgkmcnt(0)\n\ts_barrier":::"memory");
  #undef KAUG
  #undef MFA
  #undef SETQAUG
  #undef DMA_K
  #undef DMA_V
  #undef CMASK
  #undef START
  #undef RESC
  #undef ROT
}
constexpr int ATTN_LDS_BYTES=LDS_BYTES;
struct AttnTensors { const bf16* Q; const bf16* K; const bf16* V; bf16* O; const uint2* AUG; };
struct AttnUnit { int bh; int qb; };
struct StaticOrder {
  int vcu,grid;
  __device__ __forceinline__ explicit StaticOrder(int grid_,int vcu_):vcu(vcu_),grid(grid_){}
  __device__ __forceinline__ bool next(int i,AttnUnit&u)const{ const int p=vcu+(i>>1)*grid; if(p>=BATCH*NHEAD*4)return false; const int s=p&3; u.bh=p>>2; u.qb=(i&1)?(NQB-1-s):s; return true; }
  __device__ __forceinline__ void a_ready(const AttnUnit&)const{}
  __device__ __forceinline__ void done(const AttnUnit&)const{}
};
template<class Sched,int THRL=8> __device__ __forceinline__ void attn_phase(char*lds,const AttnTensors&T,const Sched&S){
  AttnUnit u;
  for(int i=0;S.next(i,u);++i){ S.a_ready(u); attn_unit<THRL>(u.bh/NHEAD,u.bh%NHEAD,u.qb,T.Q,T.K,T.V,T.O,T.AUG,lds); S.done(u); }
}
#undef SBAR
#undef WAIT_BAR
}
constexpr int NWAVES = 8;
constexpr int MP = 16384, MS = 256, MT = MP + MS;
constexpr int DM = 1024, NQ = 2048, FF = 2816, FF2 = 5632, INW = 2056;
constexpr int TP = 2048, NB = 8, NH = 8, TS = 8, NSEQ = 32, NPAST = 8192, NPG = 64;
constexpr float LN_EPS = 1e-5f, ALPHA = 1.189207115002721f;
constexpr float LOG2E = 1.4426950408889634f;
constexpr size_t O_YP = 0, O_YS = O_YP + (size_t)MP * DM, O_KP = O_YS + (size_t)MS * DM, O_VP = O_KP + (size_t)MP * 512, O_LFP = O_VP + (size_t)MP * 512,
                 O_PLP = O_LFP + (size_t)MP * 8, O_CVP = O_PLP + (size_t)NB * 15 * 512, O_KS = O_CVP + (size_t)NB * 2 * FF2, O_VS = O_KS + (size_t)MS * 512,
                 O_LFS = O_VS + (size_t)MS * 512, O_PLS = O_LFS + (size_t)MS * 8, O_CVS = O_PLS + (size_t)NSEQ * 15 * 512, O_END = O_CVS + (size_t)NSEQ * 2 * FF2;
constexpr size_t MiB = 1u << 20;
constexpr size_t WS_CTL = 0, CTL_ZERO_BYTES = 1 * MiB;
constexpr size_t WS_WIN = 2 * MiB, WS_WOUT = 6 * MiB, WS_WUP = 8 * MiB, WS_WDN = 19 * MiB;
constexpr size_t WS_LOGF = 25 * MiB, WS_AUG = 26 * MiB, WS_BP = 27 * MiB, WS_PML = 35 * MiB, WS_PO = 36 * MiB;
constexpr size_t WS_XB = 40 * MiB, WS_QKVU = 73 * MiB, WS_AO = 138 * MiB, WS_MIX = 171 * MiB, WS_X1 = 236 * MiB, WS_X1B = 301 * MiB, WS_HB = 334 * MiB, WS_G = 513 * MiB, WS_END = 603 * MiB;
static_assert(WS_WUP + (size_t)FF2 * DM * 2 <= WS_WDN && WS_WDN + (size_t)DM * FF * 2 <= WS_LOGF && WS_XB + (size_t)MT * DM * 2 <= WS_QKVU && WS_QKVU + (size_t)MT * NQ * 2 <= WS_AO &&
              WS_AO + (size_t)MT * DM * 2 <= WS_MIX && WS_MIX + (size_t)MT * DM * 4 <= WS_X1 && WS_X1 + (size_t)MT * DM * 4 <= WS_X1B && WS_X1B + (size_t)MT * DM * 2 <= WS_HB &&
              WS_HB + (size_t)MT * FF2 * 2 <= WS_G && WS_G + (size_t)MT * FF * 2 <= WS_END, "d_ws map");
constexpr int CW_TMO = 0, CW_CODE = 1, CW_BAR = 4096;
constexpr int RING_OFF = 0, RING_BYTES = 131072;
constexpr int LDSCTL_OFF = RING_BYTES, MISC_OFF = LDSCTL_OFF + 320;
constexpr int LDS_BYTES = 147456;
static_assert(MISC_OFF + 128 <= LDS_BYTES, "LDS map");
#define GAS __attribute__((address_space(1)))
#define LAS __attribute__((address_space(3)))
typedef unsigned short bf16;
typedef unsigned v4u __attribute__((ext_vector_type(4)));
typedef float f32x4 __attribute__((ext_vector_type(4)));
typedef short bf16x8 __attribute__((ext_vector_type(8)));
typedef GAS unsigned gu32;
typedef GAS unsigned long long gu64;
#define RLX_AGENT __ATOMIC_RELAXED, __HIP_MEMORY_SCOPE_AGENT
#define LDS_WAIT() asm volatile("s_waitcnt lgkmcnt(0)" ::: "memory")
#define VM_WAIT() asm volatile("s_waitcnt vmcnt(0)" ::: "memory")
__device__ __forceinline__ unsigned long long rt() { return __builtin_amdgcn_s_memrealtime(); }
__device__ __forceinline__ unsigned f2bf(float f) { unsigned u = __builtin_bit_cast(unsigned, f); return (u + 0x7fffu + ((u >> 16) & 1u)) >> 16; }
__device__ __forceinline__ unsigned pk2(float lo, float hi) { return f2bf(lo) | (f2bf(hi) << 16); }

#define XB_TMO      128
#define XB_XCNT(j)  (256  + 64 * (j))
#define XB_XSUB(j)  (1280 + 64 * (j))
#define XB_XGEN(j)  (2304 + 64 * (j))
#define XB_TOP      3328
#define XB_TOPGEN   3392
#define XCD_BAR_WORDS 3456
#define XB_SPIN_CAP (1u << 18)

__device__ __forceinline__ unsigned xb_ld(unsigned* p)              { return __hip_atomic_load(p, __ATOMIC_RELAXED, __HIP_MEMORY_SCOPE_AGENT); }
__device__ __forceinline__ unsigned xb_add(unsigned* p, unsigned v) { return __hip_atomic_fetch_add(p, v, __ATOMIC_RELAXED, __HIP_MEMORY_SCOPE_AGENT); }
__device__ __forceinline__ unsigned xb_xcc_id() { return (unsigned)__builtin_amdgcn_s_getreg((3 << 11) | 20) & 0xFu; }
#define XB_SPIN(cond, bar) do { unsigned _sp = 0; while (cond) { __builtin_amdgcn_s_sleep(1); \
    if ((++_sp & 255u) == 0u) { if (xb_ld(&(bar)[XB_TMO])) break; if (_sp > XB_SPIN_CAP) { atomicAdd(&(bar)[XB_TMO], 1u); break; } } } } while (0)

struct XcdBarrier {
    unsigned* bar; unsigned x;
    volatile LAS unsigned* st;
};

__device__ __forceinline__ XcdBarrier xcd_barrier_post(unsigned* bar, volatile LAS unsigned* st) {
    XcdBarrier b; b.bar = bar; b.x = xb_xcc_id(); b.st = st;
    if (threadIdx.x == 0) (void)xb_add(&bar[XB_XCNT(b.x)], 1u);
    return b;
}
__device__ __forceinline__ void xcd_barrier_complete(unsigned* bar, unsigned x, unsigned& nloc, unsigned& nx) {
    const unsigned G = gridDim.x * gridDim.y * gridDim.z;
    unsigned sum, cnt, mine, sp = 0u;
    for (;;) {
        sum = 0u; cnt = 0u; mine = 0u;
#pragma unroll
        for (unsigned j = 0; j < 16; ++j) { const unsigned c = xb_ld(&bar[XB_XCNT(j)]); sum += c; cnt += (c > 0u) ? 1u : 0u; mine = (j == x) ? c : mine; }
        if (sum == G) break;
        __builtin_amdgcn_s_sleep(1);
        if ((++sp & 255u) == 0u) { if (xb_ld(&bar[XB_TMO])) break; if (sp > XB_SPIN_CAP) { atomicAdd(&bar[XB_TMO], 1u); break; } }
    }
    nloc = mine > 0u ? mine : 1u; nx = cnt > 0u ? cnt : 1u;
}

__device__ __forceinline__ void xcd_barrier(const XcdBarrier& b) {
    asm volatile("s_waitcnt vmcnt(0)" ::: "memory");
    __syncthreads();
    if (threadIdx.x == 0) {
        unsigned* bar = b.bar;
        __builtin_amdgcn_s_waitcnt(0);
        unsigned nloc = b.st[0], nx = b.st[1];
        if (nloc == 0u) { xcd_barrier_complete(bar, b.x, nloc, nx); b.st[0] = nloc; b.st[1] = nx; }
        const unsigned old = xb_add(&bar[XB_XSUB(b.x)], 1u);
        const unsigned gen = old / nloc;
        if (old + 1u == (gen + 1u) * nloc) {
            __builtin_amdgcn_fence(__ATOMIC_RELEASE, "agent");
            asm volatile("s_waitcnt vmcnt(0)" ::: "memory");
            const unsigned og = xb_add(&bar[XB_TOP], 1u);
            const unsigned tg = og / nx;
            if (og + 1u == (tg + 1u) * nx) xb_add(&bar[XB_TOPGEN], 1u);
            else XB_SPIN(xb_ld(&bar[XB_TOPGEN]) == tg, bar);
            __builtin_amdgcn_fence(__ATOMIC_ACQUIRE, "agent");
            xb_add(&bar[XB_XGEN(b.x)], 1u);
            asm volatile("s_waitcnt vmcnt(0)" ::: "memory");
        } else {
            XB_SPIN(xb_ld(&bar[XB_XGEN(b.x)]) == gen, bar);
            __builtin_amdgcn_fence(__ATOMIC_ACQUIRE, "agent");
            asm volatile("s_waitcnt vmcnt(0)" ::: "memory");
        }
    }
    __syncthreads();
}
struct Frame {
    LAS unsigned char* lds;
    volatile LAS unsigned* MISC;
    gu32* ctl;
    int tid, lane, wave;
    int vcu, G;
};
__device__ __forceinline__ float wave_sum(float v) {
#pragma unroll
    for (int o = 1; o < 64; o <<= 1) v += __shfl_xor(v, o);
    return v;
}
__device__ __forceinline__ float bf2f(unsigned short b) { return __builtin_bit_cast(float, (unsigned)b << 16); }
__device__ __forceinline__ float bflo(unsigned w) { return __builtin_bit_cast(float, w << 16); }
__device__ __forceinline__ float bfhi(unsigned w) { return __builtin_bit_cast(float, w & 0xffff0000u); }

__device__ __forceinline__ void tr_item(const float* W, int ldw, int src_c0, int N, bf16* WT, int ldt, int dst_r0, LAS float* scr, int item, int lane) {
    const int nblk = N / 32, kb = item / nblk, nb = item % nblk, k0 = 64 * kb, n0 = 32 * nb;
#pragma unroll 8
    for (int i = 0; i < 32; ++i) { const int kk = 2 * i + (lane >> 5); scr[kk * 33 + (lane & 31)] = W[(size_t)(k0 + kk) * ldw + src_c0 + n0 + (lane & 31)]; }
    LDS_WAIT(); asm volatile("" ::: "memory");
    const int c = lane & 7;
#pragma unroll
    for (int j = 0; j < 4; ++j) { const int n = (lane >> 3) + 8 * j; const LAS float* s = scr + (8 * c) * 33 + n;
        v4u o; o.x = pk2(s[0 * 33], s[1 * 33]); o.y = pk2(s[2 * 33], s[3 * 33]); o.z = pk2(s[4 * 33], s[5 * 33]); o.w = pk2(s[6 * 33], s[7 * 33]);
        *(GAS v4u*)(WT + (size_t)(dst_r0 + n0 + n) * ldt + k0 + 8 * c) = o; }
    LDS_WAIT(); asm volatile("" ::: "memory");
}
__device__ __forceinline__ void weff_item(const float* wpool, const float* pscale, const float* wout, bf16* WT, int item, int lane) {
    const int nb = item & 15, cb = (item >> 4) & 7, g = item >> 7, n = nb * 64 + lane, c0 = cb * 16;
    float acc[16];
#pragma unroll
    for (int i = 0; i < 16; ++i) acc[i] = 0.f;
    const float* wp = wpool + ((size_t)g * 128 + c0) * 128;
    for (int e = 0; e < 128; ++e) {
        const float wv = wout[(size_t)(512 + g * 128 + e) * DM + n] * pscale[g * 128 + e];
#pragma unroll
        for (int i = 0; i < 16; ++i) acc[i] += wp[i * 128 + e] * wv;
    }
    v4u o0, o1; o0.x = pk2(acc[0], acc[1]); o0.y = pk2(acc[2], acc[3]); o0.z = pk2(acc[4], acc[5]); o0.w = pk2(acc[6], acc[7]);
    o1.x = pk2(acc[8], acc[9]); o1.y = pk2(acc[10], acc[11]); o1.z = pk2(acc[12], acc[13]); o1.w = pk2(acc[14], acc[15]);
    GAS v4u* d = (GAS v4u*)(WT + (size_t)n * DM + 512 + g * 128 + c0); d[0] = o0; d[1] = o1;
}
__device__ __forceinline__ float log_sigmoid(float x) { return fminf(x, 0.f) - log1pf(expf(-fabsf(x))); }
__device__ __forceinline__ void x_row(const float* xrow, bf16* orow, const LAS float* wfT, const float* bf, float* logf_out, float* logf_ws, int lane) {
    const GAS f32x4* xr = (const GAS f32x4*)xrow + lane;
    f32x4 v[4];
#pragma unroll
    for (int j = 0; j < 4; ++j) v[j] = xr[64 * j];
    GAS unsigned long long* o8 = (GAS unsigned long long*)orow + lane;
#pragma unroll
    for (int j = 0; j < 4; ++j) o8[64 * j] = (unsigned long long)pk2(v[j].x, v[j].y) | ((unsigned long long)pk2(v[j].z, v[j].w) << 32);
    float z[8];
#pragma unroll
    for (int e = 0; e < 8; ++e) { float s = 0.f;
#pragma unroll
        for (int j = 0; j < 4; ++j) { const f32x4 w = *(const LAS f32x4*)(wfT + e * 1024 + 256 * j + 4 * lane); s += (v[j].x * w.x + v[j].y * w.y) + (v[j].z * w.z + v[j].w * w.w); }
        z[e] = wave_sum(s); }
    float mine = z[0];
#pragma unroll
    for (int e = 1; e < 8; ++e) mine = (lane == e) ? z[e] : mine;
    if (lane < 8) { const float lf = log_sigmoid(mine + bf[lane]); logf_out[lane] = lf; logf_ws[lane] = lf; }
}
__device__ __forceinline__ void bp_item(Frame& F, const float* clogf, const int* pt, float* BP, int item) {
    const int b = item >> 3, h = item & 7, tid = F.tid;
    const int page = pt[b * NPG + (tid >> 3)], slot0 = (tid & 7) * 16;
    const float* src = clogf + ((size_t)page * 128 + slot0) * 8 + h;
    float v[16];
#pragma unroll
    for (int i = 0; i < 16; ++i) v[i] = src[i * 8];
    float suf[16]; float run = 0.f;
#pragma unroll
    for (int i = 15; i >= 0; --i) { suf[i] = run; run += v[i]; }
    float tot = run, inc = tot;
#pragma unroll
    for (int o = 1; o < 64; o <<= 1) { const float t = __shfl_down(inc, o); if (F.lane + o < 64) inc += t; }
    LAS float* wt = (LAS float*)(F.lds + RING_OFF);
    __syncthreads();
    if (F.lane == 0) wt[F.wave] = inc;
    __syncthreads();
    float after = inc - tot;
#pragma unroll
    for (int w = 0; w < 8; ++w) if (w > F.wave) after += wt[w];
    float* dst = BP + ((size_t)item * NPAST + tid * 16);
#pragma unroll
    for (int i = 0; i < 16; i += 4) *(f32x4*)(dst + i) = (f32x4){(suf[i] + after) * LOG2E, (suf[i + 1] + after) * LOG2E, (suf[i + 2] + after) * LOG2E, (suf[i + 3] + after) * LOG2E};
}
__device__ __forceinline__ void aug_item(const float* logf, uint2* AUG, int bh, int lane) {
    const int b = bh >> 3, h = bh & 7;
    const float* src = logf + ((size_t)b * TP + lane * 32) * 8 + h;
    float v[32]; float run = 0.f;
#pragma unroll
    for (int i = 0; i < 32; ++i) { run += src[i * 8]; v[i] = run; }
    float inc = run;
#pragma unroll
    for (int o = 1; o < 64; o <<= 1) { const float t = __shfl_up(inc, o); if (lane >= o) inc += t; }
    const float before = inc - run;
    uint2* dst = AUG + (size_t)bh * TP + lane * 32;
#pragma unroll
    for (int i = 0; i < 32; ++i) { const float x = -(v[i] + before) * LOG2E;
        const unsigned h0 = f2bf(x); const float r1 = x - __builtin_bit_cast(float, h0 << 16);
        const unsigned h1 = f2bf(r1); const float r2 = r1 - __builtin_bit_cast(float, h1 << 16);
        const unsigned h2 = f2bf(r2);
        dst[i] = make_uint2(h0 | (h1 << 16), h2); }
}
__device__ __forceinline__ void pool_item(const bf16* QKVU, const float* spool, bf16* AO, int idx) {
    const int cc = idx & 63, rb = idx >> 6, r0 = rb * 8, c = cc * 8, g = cc >> 4, w = 2 << g;
    const bool samp = r0 >= MP; const int t0 = samp ? 0 : (r0 & (TP - 1)); const int sb = (r0 - MP) >> 3;
    const bf16* ub = QKVU + (size_t)r0 * NQ + 1536 + c;
    const float* sp = spool + (size_t)sb * 15 * 512 + c;
    float S[8];
#pragma unroll
    for (int i = 0; i < 8; ++i) S[i] = 0.f;
    for (int j = 1; j < w; ++j) { const int tp = t0 - j;
        if (tp >= 0) { const v4u x = *(const GAS v4u*)(ub - (long)j * NQ);
            S[0] += bflo(x.x); S[1] += bfhi(x.x); S[2] += bflo(x.y); S[3] += bfhi(x.y); S[4] += bflo(x.z); S[5] += bfhi(x.z); S[6] += bflo(x.w); S[7] += bfhi(x.w); }
        else if (samp) { const f32x4 a = *(const f32x4*)(sp + (15 + tp) * 512), b2 = *(const f32x4*)(sp + (15 + tp) * 512 + 4);
            S[0] += a.x; S[1] += a.y; S[2] += a.z; S[3] += a.w; S[4] += b2.x; S[5] += b2.y; S[6] += b2.z; S[7] += b2.w; } }
    for (int i = 0; i < 8; ++i) { const int t = t0 + i;
        const v4u x = *(const GAS v4u*)(ub + (size_t)i * NQ);
        float u8[8] = {bflo(x.x), bfhi(x.x), bflo(x.y), bfhi(x.y), bflo(x.z), bfhi(x.z), bflo(x.w), bfhi(x.w)};
        const float cnt = samp ? (float)w : (float)((t + 1) < w ? (t + 1) : w); const float inv = 1.0f / cnt;
        float o[8];
#pragma unroll
        for (int k = 0; k < 8; ++k) { S[k] += u8[k]; o[k] = S[k] * inv - u8[k]; }
        v4u ov; ov.x = pk2(o[0], o[1]); ov.y = pk2(o[2], o[3]); ov.z = pk2(o[4], o[5]); ov.w = pk2(o[6], o[7]);
        *(GAS v4u*)(AO + (size_t)(r0 + i) * DM + 512 + c) = ov;
        const int to = t - w + 1;
        if (to >= 0) { const v4u y = *(const GAS v4u*)(ub + (long)(i - w + 1) * NQ);
            S[0] -= bflo(y.x); S[1] -= bfhi(y.x); S[2] -= bflo(y.y); S[3] -= bfhi(y.y); S[4] -= bflo(y.z); S[5] -= bfhi(y.z); S[6] -= bflo(y.w); S[7] -= bfhi(y.w); }
        else if (samp) { const f32x4 a = *(const f32x4*)(sp + (15 + to) * 512), b2 = *(const f32x4*)(sp + (15 + to) * 512 + 4);
            S[0] -= a.x; S[1] -= a.y; S[2] -= a.z; S[3] -= a.w; S[4] -= b2.x; S[5] -= b2.y; S[6] -= b2.z; S[7] -= b2.w; } }
}
constexpr int SD_KT = 32, SD_KPITCH = 144, SD_VPITCH = 80, SD_WAVE_LDS = SD_KT * SD_KPITCH + 64 * SD_VPITCH;
static_assert(SD_WAVE_LDS * NWAVES <= RING_BYTES, "sample attention LDS");
struct SdTile { f32x4 k[8], v[8], bias[2]; };
__device__ __forceinline__ void sd_load(SdTile& T, const float* ck, const float* cv, const float* bp, const int* ptb, int tt, int h, int fr, int fq) {
    const int page = ptb[tt >> 2], slot0 = (tt & 3) * SD_KT;
    const size_t base = (((size_t)page * 128 + slot0 + fq) * 8 + h) * 64 + 4 * fr;
#pragma unroll
    for (int i = 0; i < 8; ++i) { T.k[i] = __builtin_nontemporal_load((const f32x4*)(ck + base + (size_t)i * 4 * 512)); T.v[i] = __builtin_nontemporal_load((const f32x4*)(cv + base + (size_t)i * 4 * 512)); }
    const float* b = bp + (tt >> 2) * 128 + slot0 + 8 * fq;
    T.bias[0] = *(const f32x4*)b; T.bias[1] = *(const f32x4*)(b + 4);
}
__device__ __forceinline__ void sdec_unit(Frame& F, int b, int sp, const float* ck, const float* cv, const int* pt, const bf16* QKVU, const float* BP, float* PML, float* PO) {
    const int h = F.wave, lane = F.lane, fr = lane & 15, fq = lane >> 4;
    LAS unsigned char* kim = F.lds + RING_OFF + F.wave * SD_WAVE_LDS; LAS unsigned char* vim = kim + SD_KT * SD_KPITCH;
    bf16x8 qf[2];
#pragma unroll
    for (int ks = 0; ks < 2; ++ks) { qf[ks] = (bf16x8){0, 0, 0, 0, 0, 0, 0, 0}; if (fr < 8) qf[ks] = *(const bf16x8*)(QKVU + (size_t)(MP + 8 * b + fr) * NQ + h * 64 + 32 * ks + 8 * fq); }
    const int* ptb = pt + b * NPG + 8 * sp;
    const float* bp = BP + ((size_t)(b * 8 + h) * NPAST + (size_t)sp * 1024);
    float m = -INFINITY, l = 0.f; f32x4 o[4];
#pragma unroll
    for (int d = 0; d < 4; ++d) o[d] = (f32x4){0.f, 0.f, 0.f, 0.f};
    SdTile cur, nxt;
    sd_load(cur, ck, cv, bp, ptb, 0, h, fr, fq);
    for (int tt = 0; tt < 32; ++tt) {
        if (tt + 1 < 32) sd_load(nxt, ck, cv, bp, ptb, tt + 1, h, fr, fq);
#pragma unroll
        for (int i = 0; i < 8; ++i) { const int key = 4 * i + fq;
            *(LAS unsigned long long*)(kim + key * SD_KPITCH + 8 * fr) = (unsigned long long)pk2(cur.k[i].x, cur.k[i].y) | ((unsigned long long)pk2(cur.k[i].z, cur.k[i].w) << 32);
            *(LAS unsigned short*)(vim + (4 * fr + 0) * SD_VPITCH + key * 2) = (unsigned short)f2bf(cur.v[i].x);
            *(LAS unsigned short*)(vim + (4 * fr + 1) * SD_VPITCH + key * 2) = (unsigned short)f2bf(cur.v[i].y);
            *(LAS unsigned short*)(vim + (4 * fr + 2) * SD_VPITCH + key * 2) = (unsigned short)f2bf(cur.v[i].z);
            *(LAS unsigned short*)(vim + (4 * fr + 3) * SD_VPITCH + key * 2) = (unsigned short)f2bf(cur.v[i].w); }
        asm volatile("s_waitcnt lgkmcnt(0)" ::: "memory");
        f32x4 s[2];
#pragma unroll
        for (int j = 0; j < 2; ++j) { s[j] = (f32x4){0.f, 0.f, 0.f, 0.f}; const int key = 8 * (fr >> 2) + 4 * j + (fr & 3);
#pragma unroll
            for (int ks = 0; ks < 2; ++ks) { const bf16x8 a = *(const LAS bf16x8*)(kim + key * SD_KPITCH + 16 * fq + 64 * ks); s[j] = __builtin_amdgcn_mfma_f32_16x16x32_bf16(a, qf[ks], s[j], 0, 0, 0); } }
        s[0] += cur.bias[0]; s[1] += cur.bias[1];
        float mt = fmaxf(fmaxf(fmaxf(s[0].x, s[0].y), fmaxf(s[0].z, s[0].w)), fmaxf(fmaxf(s[1].x, s[1].y), fmaxf(s[1].z, s[1].w)));
        mt = fmaxf(mt, __shfl_xor(mt, 16)); mt = fmaxf(mt, __shfl_xor(mt, 32));
        const float mn = fmaxf(m, mt), al = __builtin_amdgcn_exp2f(m - mn); m = mn;
        f32x4 p0, p1;
        p0.x = __builtin_amdgcn_exp2f(s[0].x - mn); p0.y = __builtin_amdgcn_exp2f(s[0].y - mn); p0.z = __builtin_amdgcn_exp2f(s[0].z - mn); p0.w = __builtin_amdgcn_exp2f(s[0].w - mn);
        p1.x = __builtin_amdgcn_exp2f(s[1].x - mn); p1.y = __builtin_amdgcn_exp2f(s[1].y - mn); p1.z = __builtin_amdgcn_exp2f(s[1].z - mn); p1.w = __builtin_amdgcn_exp2f(s[1].w - mn);
        l = l * al + ((p0.x + p0.y) + (p0.z + p0.w)) + ((p1.x + p1.y) + (p1.z + p1.w));
        v4u pw; pw.x = pk2(p0.x, p0.y); pw.y = pk2(p0.z, p0.w); pw.z = pk2(p1.x, p1.y); pw.w = pk2(p1.z, p1.w);
        const bf16x8 pf = __builtin_bit_cast(bf16x8, pw);
#pragma unroll
        for (int d = 0; d < 4; ++d) { const bf16x8 vf = *(const LAS bf16x8*)(vim + (16 * d + fr) * SD_VPITCH + 16 * fq); o[d] = o[d] * al; o[d] = __builtin_amdgcn_mfma_f32_16x16x32_bf16(vf, pf, o[d], 0, 0, 0); }
        asm volatile("s_waitcnt lgkmcnt(0)" ::: "memory");
        cur = nxt;
    }
    l += __shfl_xor(l, 16); l += __shfl_xor(l, 32);
    if (fr < 8) { const size_t idx = (size_t)(b * 8 + h) * 8 + sp;
        if (fq == 0) { PML[idx * 16 + fr] = m; PML[idx * 16 + 8 + fr] = l; }
#pragma unroll
        for (int d = 0; d < 4; ++d) *(f32x4*)(PO + (idx * 8 + fr) * 64 + 16 * d + 4 * fq) = o[d]; }
}
__device__ __forceinline__ void scomb_item(const bf16* QKVU, const float* logf, const float* PML, const float* PO, bf16* AO, int bh, int lane) {
    const int b = bh >> 3, h = bh & 7;
    float kn[8], vn[8], bn[8]; float cum = 0.f;
#pragma unroll
    for (int t = 0; t < 8; ++t) { const bf16* r = QKVU + (size_t)(MP + 8 * b + t) * NQ + h * 64 + lane; kn[t] = bf2f(r[512]); vn[t] = bf2f(r[1024]);
        cum += logf[(size_t)(MP + 8 * b + t) * 8 + h]; bn[t] = -cum * LOG2E; }
    const float* pml = PML + (size_t)bh * 8 * 16; const float* po = PO + (size_t)bh * 8 * 8 * 64;
#pragma unroll 1
    for (int t = 0; t < 8; ++t) {
        const float qt = bf2f(QKVU[(size_t)(MP + 8 * b + t) * NQ + h * 64 + lane]);
        float sc[8]; float M = -INFINITY;
#pragma unroll
        for (int s = 0; s < 8; ++s) M = fmaxf(M, pml[s * 16 + t]);
#pragma unroll
        for (int s = 0; s < 8; ++s) { const float d = wave_sum(qt * kn[s]) + bn[s]; sc[s] = (s <= t) ? d : -INFINITY; M = fmaxf(M, sc[s]); }
        float L = 0.f, O = 0.f;
#pragma unroll
        for (int s = 0; s < 8; ++s) { const float w = __builtin_amdgcn_exp2f(pml[s * 16 + t] - M); L += w * pml[s * 16 + 8 + t]; O += w * po[(size_t)(s * 8 + t) * 64 + lane]; }
#pragma unroll
        for (int s = 0; s < 8; ++s) { const float w = __builtin_amdgcn_exp2f(sc[s] - M); L += w; O += w * vn[s]; }
        AO[(size_t)(MP + 8 * b + t) * DM + h * 64 + lane] = (bf16)f2bf(O / L);
    }
}
__device__ __forceinline__ void ln_row(const float* arow, const float* crow_, const float* g, const float* bta, float* of32, bf16* obf, int lane) {
    f32x4 v[4]; float s = 0.f;
#pragma unroll
    for (int j = 0; j < 4; ++j) { const f32x4 a = ((const GAS f32x4*)arow)[lane + 64 * j], c = ((const GAS f32x4*)crow_)[lane + 64 * j]; v[j] = a * ALPHA + c; s += (v[j].x + v[j].y) + (v[j].z + v[j].w); }
    const float mean = wave_sum(s) * (1.f / DM); float s2 = 0.f;
#pragma unroll
    for (int j = 0; j < 4; ++j) { v[j] = v[j] - mean; s2 += (v[j].x * v[j].x + v[j].y * v[j].y) + (v[j].z * v[j].z + v[j].w * v[j].w); }
    const float rstd = 1.f / sqrtf(wave_sum(s2) * (1.f / DM) + LN_EPS);
#pragma unroll
    for (int j = 0; j < 4; ++j) { const f32x4 gg = ((const GAS f32x4*)g)[lane + 64 * j], bb = ((const GAS f32x4*)bta)[lane + 64 * j]; const f32x4 y = v[j] * rstd * gg + bb;
        ((GAS f32x4*)of32)[lane + 64 * j] = y;
        if (obf) ((GAS unsigned long long*)obf)[lane + 64 * j] = (unsigned long long)pk2(y.x, y.y) | ((unsigned long long)pk2(y.z, y.w) << 32); }
}
__device__ __forceinline__ float gelu_tanh(float x) { const float y = 0.7978845608028654f * (x + 0.044715f * x * x * x); return x / (1.f + __expf(-2.f * y)); }
__device__ __forceinline__ void ld8(float (&d)[8], const bf16* p) { const v4u x = *(const GAS v4u*)p; d[0] = bflo(x.x); d[1] = bfhi(x.x); d[2] = bflo(x.y); d[3] = bfhi(x.y); d[4] = bflo(x.z); d[5] = bfhi(x.z); d[6] = bflo(x.w); d[7] = bfhi(x.w); }
__device__ __forceinline__ void ld8f(float (&d)[8], const float* p) { const f32x4 a = *(const f32x4*)p, b = *(const f32x4*)(p + 4); d[0] = a.x; d[1] = a.y; d[2] = a.z; d[3] = a.w; d[4] = b.x; d[5] = b.y; d[6] = b.z; d[7] = b.w; }
__device__ __forceinline__ void conv_item(const bf16* HB, const float* sconv, const float* wconv, const float* bconv, bf16* G, int idx) {
    const int cc = idx % 352, rb = idx / 352, r0 = rb * 8, c = cc * 8;
    const bool samp = r0 >= MP; const int t0 = samp ? 0 : (r0 & (TP - 1)); const int sb = (r0 - MP) >> 3;
    float w0g[8], w1g[8], w2g[8], bg[8], w0v[8], w1v[8], w2v[8], bv[8];
    ld8f(w0g, wconv + c); ld8f(w1g, wconv + FF2 + c); ld8f(w2g, wconv + 2 * FF2 + c); ld8f(bg, bconv + c);
    ld8f(w0v, wconv + FF + c); ld8f(w1v, wconv + FF2 + FF + c); ld8f(w2v, wconv + 2 * FF2 + FF + c); ld8f(bv, bconv + FF + c);
    float g2[8], g1[8], v2[8], v1[8];
    if (t0 >= 2) { ld8(g2, HB + (size_t)(r0 - 2) * FF2 + c); ld8(g1, HB + (size_t)(r0 - 1) * FF2 + c); ld8(v2, HB + (size_t)(r0 - 2) * FF2 + FF + c); ld8(v1, HB + (size_t)(r0 - 1) * FF2 + FF + c); }
    else if (samp) { const float* s = sconv + (size_t)sb * 2 * FF2; ld8f(g2, s + c); ld8f(g1, s + FF2 + c); ld8f(v2, s + FF + c); ld8f(v1, s + FF2 + FF + c); }
    else {
#pragma unroll
        for (int k = 0; k < 8; ++k) { g2[k] = 0.f; g1[k] = 0.f; v2[k] = 0.f; v1[k] = 0.f; } }
    for (int i = 0; i < 8; ++i) {
        float g0[8], v0[8]; ld8(g0, HB + (size_t)(r0 + i) * FF2 + c); ld8(v0, HB + (size_t)(r0 + i) * FF2 + FF + c);
        float o[8];
#pragma unroll
        for (int k = 0; k < 8; ++k) { const float hg = bg[k] + g2[k] * w0g[k] + g1[k] * w1g[k] + g0[k] * w2g[k]; const float hv = bv[k] + v2[k] * w0v[k] + v1[k] * w1v[k] + v0[k] * w2v[k];
            o[k] = gelu_tanh(hg) * hv; g2[k] = g1[k]; g1[k] = g0[k]; v2[k] = v1[k]; v1[k] = v0[k]; }
        v4u ov; ov.x = pk2(o[0], o[1]); ov.y = pk2(o[2], o[3]); ov.z = pk2(o[4], o[5]); ov.w = pk2(o[6], o[7]);
        *(GAS v4u*)(G + (size_t)(r0 + i) * FF + c) = ov; }
}
#ifndef SKIPMASK
#define SKIPMASK 0
#endif
#define PH(k) if constexpr (!((SKIPMASK >> (k)) & 1))
struct Args { const void* in[22]; float* out; unsigned char* ws; };
__global__ void __launch_bounds__(NWAVES * 64, 2) fwd_kernel(Args args) {
    extern __shared__ __attribute__((aligned(16))) unsigned char lds[];
    Frame F;
    F.lds = (LAS unsigned char*)lds;
    F.MISC = (volatile LAS unsigned*)(F.lds + MISC_OFF);
    F.tid = threadIdx.x; F.lane = F.tid & 63; F.wave = __builtin_amdgcn_readfirstlane(F.tid >> 6);
    F.G = gridDim.x; { const int bx = blockIdx.x; F.vcu = (F.G % 8 == 0) ? (bx % 8) * (F.G / 8) + bx / 8 : bx; }
    unsigned char* ws = args.ws;
    F.ctl = (gu32*)(ws + WS_CTL);
    const float* x_p = (const float*)args.in[0]; const float* x_s = (const float*)args.in[1];
    const float* cache_k = (const float*)args.in[2]; const float* cache_v = (const float*)args.in[3]; const float* cache_lf = (const float*)args.in[4];
    const float* st_pool = (const float*)args.in[5]; const float* st_conv = (const float*)args.in[6]; const int* ptab = (const int*)args.in[7];
    const float* w_in = (const float*)args.in[8]; const float* b_f = (const float*)args.in[9]; const float* w_pool = (const float*)args.in[10]; const float* p_scale = (const float*)args.in[11];
    const float* w_out = (const float*)args.in[12]; const float* ln1_g = (const float*)args.in[13]; const float* ln1_b = (const float*)args.in[14];
    const float* w_up = (const float*)args.in[15]; const float* b_up = (const float*)args.in[16]; const float* w_conv = (const float*)args.in[17]; const float* b_conv = (const float*)args.in[18];
    const float* w_down = (const float*)args.in[19]; const float* ln2_g = (const float*)args.in[20]; const float* ln2_b = (const float*)args.in[21];
    float* out = args.out;
    bf16* Wt_in = (bf16*)(ws + WS_WIN); bf16* Wt_out = (bf16*)(ws + WS_WOUT); bf16* Wt_up = (bf16*)(ws + WS_WUP); bf16* Wt_dn = (bf16*)(ws + WS_WDN);
    float* LOGF = (float*)(ws + WS_LOGF); uint2* AUG = (uint2*)(ws + WS_AUG); float* BP = (float*)(ws + WS_BP); float* PML = (float*)(ws + WS_PML); float* PO = (float*)(ws + WS_PO);
    bf16* XB = (bf16*)(ws + WS_XB); bf16* QKVU = (bf16*)(ws + WS_QKVU); bf16* AO = (bf16*)(ws + WS_AO); float* MIX = (float*)(ws + WS_MIX); float* X1 = (float*)(ws + WS_X1);
    bf16* X1B = (bf16*)(ws + WS_X1B); bf16* HB = (bf16*)(ws + WS_HB); bf16* GB = (bf16*)(ws + WS_G);

    for (int u = F.tid; u < (LDS_BYTES - LDSCTL_OFF) / 4; u += NWAVES * 64) ((LAS unsigned*)(F.lds + LDSCTL_OFF))[u] = 0u;
    __syncthreads();
    XcdBarrier bar = xcd_barrier_post((unsigned*)(F.ctl + CW_BAR), F.MISC + 8);
    const int NGW = F.G * NWAVES, NGT = F.G * NWAVES * 64;
    int gw, gt;
#define REFRAME() do { int t_ = threadIdx.x; asm volatile("" : "+v"(t_)); F.tid = t_; F.lane = t_ & 63; F.wave = __builtin_amdgcn_readfirstlane(t_ >> 6); gw = F.vcu * NWAVES + F.wave; gt = F.vcu * (NWAVES * 64) + F.tid; } while (0)
#define SEAM() do { xcd_barrier(bar); REFRAME(); } while (0)
    REFRAME();

    {
        LAS float* scr = (LAS float*)(F.lds + RING_OFF + F.wave * 16384);
        constexpr int I_IN1 = 16 * 48, I_IN2 = 16 * 16, I_OUT = 8 * 32, I_UP = 16 * 176, I_DN = 44 * 32, I_EFF = 512;
        constexpr int NIT = I_IN1 + I_IN2 + I_OUT + I_UP + I_DN + I_EFF;
        for (int it = gw; it < NIT; it += NGW) {
            int r = it;
            if (r < I_IN1) { tr_item(w_in, INW, 0, 1536, Wt_in, DM, 0, scr, r, F.lane); continue; } r -= I_IN1;
            if (r < I_IN2) { tr_item(w_in, INW, 1544, 512, Wt_in, DM, 1536, scr, r, F.lane); continue; } r -= I_IN2;
            if (r < I_OUT) { tr_item(w_out, DM, 0, DM, Wt_out, DM, 0, scr, r, F.lane); continue; } r -= I_OUT;
            if (r < I_UP) { tr_item(w_up, FF2, 0, FF2, Wt_up, DM, 0, scr, r, F.lane); continue; } r -= I_UP;
            if (r < I_DN) { tr_item(w_down, DM, 0, DM, Wt_dn, FF, 0, scr, r, F.lane); continue; } r -= I_DN;
            weff_item(w_pool, p_scale, w_out, Wt_out, r, F.lane);
        }
        __syncthreads();
        LAS float* wfT = (LAS float*)(F.lds + RING_OFF);
        for (int i = F.tid; i < 8 * 1024; i += NWAVES * 64) { const int e = i & 7, k = i >> 3; wfT[e * 1024 + k] = w_in[(size_t)k * INW + 1536 + e]; }
        __syncthreads();
        for (int m = gw; m < MT; m += NGW) {
            const bool samp = m >= MP; const float* xr = samp ? x_s + (size_t)(m - MP) * DM : x_p + (size_t)m * DM;
            float* lo = samp ? out + O_LFS + (size_t)(m - MP) * 8 : out + O_LFP + (size_t)m * 8;
            x_row(xr, XB + (size_t)m * DM, wfT, b_f, lo, LOGF + (size_t)m * 8, F.lane);
        }
        __syncthreads();
        PH(6) for (int it = F.vcu; it < NSEQ * NH; it += F.G) bp_item(F, cache_lf, ptab, BP, it);
        for (int i = gt; i < NSEQ * 7 * 128; i += NGT) { const int c4 = i & 127, r = (i >> 7) % 7, b = i / (7 * 128);
            *(f32x4*)(out + O_PLS + ((size_t)b * 15 + r) * 512 + 4 * c4) = *(const f32x4*)(st_pool + ((size_t)b * 15 + 8 + r) * 512 + 4 * c4); }
    }
    SEAM();

    {
        PH(4) if (gw < NB * NH) aug_item(LOGF, AUG, gw, F.lane);
        pg8::Gemm g{XB, Wt_in, MT, NQ, DM}; pg8::StaticOrder S; S.init(MT, NQ, F.G, (int)blockIdx.x);
        pg8::EpiWin E{QKVU, out + O_KP, out + O_KS, out + O_PLP, out + O_PLS, attn_body::C2};
        pg8::gemm_phase<pg8::EpiWin, pg8::StaticOrder, PG8_ALIGN, PG8_SP2>(F.lds + RING_OFF, g, S, E);
    }
    SEAM();

    {
        const attn_body::AttnTensors AT{(const attn_body::bf16*)QKVU, (const attn_body::bf16*)(QKVU + 512), (const attn_body::bf16*)(QKVU + 1024), (attn_body::bf16*)AO, AUG};
        const attn_body::StaticOrder S((int)F.G, F.vcu);
        PH(0) attn_body::attn_phase<attn_body::StaticOrder>((char*)lds + RING_OFF, AT, S);
        PH(1) for (int i = gt; i < (MT / 8) * 64; i += NGT) pool_item(QKVU, st_pool, AO, i);
        __syncthreads();
        PH(2) for (int it = F.vcu; it < NSEQ * 8; it += F.G) { sdec_unit(F, it >> 3, it & 7, cache_k, cache_v, ptab, QKVU, BP, PML, PO); __syncthreads(); }
    }
    SEAM();
    PH(3) for (int it = gw; it < NSEQ * NH; it += NGW) scomb_item(QKVU, LOGF, PML, PO, AO, it, F.lane);
    SEAM();

    {
        pg8::Gemm g{AO, Wt_out, MT, DM, DM}; pg8::StaticOrder S; S.init(MT, DM, F.G, (int)blockIdx.x);
        pg8::EpiF32 E{MIX, DM};
        pg8::gemm_phase<pg8::EpiF32, pg8::StaticOrder, PG8_ALIGN, PG8_SP2>(F.lds + RING_OFF, g, S, E);
    }
    SEAM();
    for (int m = gw; m < MT; m += NGW) { const float* xr = m >= MP ? x_s + (size_t)(m - MP) * DM : x_p + (size_t)m * DM;
        ln_row(xr, MIX + (size_t)m * DM, ln1_g, ln1_b, X1 + (size_t)m * DM, X1B + (size_t)m * DM, F.lane); }
    SEAM();

    {
        pg8::Gemm g{X1B, Wt_up, MT, FF2, DM}; pg8::StaticOrder S; S.init(MT, FF2, F.G, (int)blockIdx.x);
        pg8::EpiUp E{HB, b_up, out + O_CVP, out + O_CVS};
        pg8::gemm_phase<pg8::EpiUp, pg8::StaticOrder, PG8_ALIGN, PG8_SP2>(F.lds + RING_OFF, g, S, E);
    }
    SEAM();
    PH(5) for (int i = gt; i < (MT / 8) * 352; i += NGT) conv_item(HB, st_conv, w_conv, b_conv, GB, i);
    SEAM();

    {
        pg8::Gemm g{GB, Wt_dn, MT, DM, FF}; pg8::StaticOrder S; S.init(MT, DM, F.G, (int)blockIdx.x);
        pg8::EpiF32 E{MIX, DM};
        pg8::gemm_phase<pg8::EpiF32, pg8::StaticOrder, PG8_ALIGN, PG8_SP2>(F.lds + RING_OFF, g, S, E);
    }
    SEAM();
    for (int m = gw; m < MT; m += NGW) { float* yo = m >= MP ? out + O_YS + (size_t)(m - MP) * DM : out + O_YP + (size_t)m * DM;
        ln_row(X1 + (size_t)m * DM, MIX + (size_t)m * DM, ln2_g, ln2_b, yo, nullptr, F.lane); }
}

extern "C" void kernel_launch(void* const* d_in, const int* in_sizes, int n_in, void* d_out, int out_size, void* d_ws, size_t ws_size, hipStream_t stream) {
    static int grid = 0;
    if (grid == 0) {
        if (n_in != 22 || (size_t)out_size != O_END || ws_size < WS_END) { fprintf(stderr, "kernel_launch: unexpected shapes: n_in %d out %d ws %zu (want 22, %zu, >= %zu)\n", n_in, out_size, ws_size, (size_t)O_END, (size_t)WS_END); grid = -1; return; }
        int dev = 0, cus = 0, per_cu = 0;
        if (hipGetDevice(&dev) != hipSuccess || hipDeviceGetAttribute(&cus, hipDeviceAttributeMultiprocessorCount, dev) != hipSuccess) { grid = -1; return; }
        if (hipFuncSetAttribute((const void*)fwd_kernel, hipFuncAttributeMaxDynamicSharedMemorySize, LDS_BYTES) != hipSuccess) { fprintf(stderr, "kernel_launch: hipFuncSetAttribute failed\n"); grid = -1; return; }
        if (hipOccupancyMaxActiveBlocksPerMultiprocessor(&per_cu, (const void*)fwd_kernel, NWAVES * 64, LDS_BYTES) != hipSuccess || per_cu < 1) fprintf(stderr, "kernel_launch: occupancy query says %d\n", per_cu);
        (void)hipGetLastError();
        grid = cus;
    }
    if (grid < 0) return;
    if (hipMemsetAsync((char*)d_ws + WS_CTL, 0, CTL_ZERO_BYTES, stream) != hipSuccess) return;
    Args a{};
    for (int i = 0; i < 22; ++i) a.in[i] = d_in[i];
    a.out = (float*)d_out; a.ws = (unsigned char*)d_ws;
    hipLaunchKernelGGL(fwd_kernel, dim3(grid), dim3(NWAVES * 64), LDS_BYTES, stream, a);
}
```
